# Optimizing an MI355X kernel written in HIP

```python
import jax
import jax.numpy as jnp
from jax import lax
import numpy as np

D_MODEL = 2048
BATCH = 2
SEQ = 8192
DEPTH = 2

GRID_W = 64
CTX_LEN = 256
EPS = 1e-6
NEG = -1e30
CHUNK = 64
D_FF = 4 * D_MODEL
N_BRANCH = 4

RW_WIDTH = D_MODEL // 4
RW_HEAD = 64
RW_HEADS = RW_WIDTH // RW_HEAD
RW_DECAY_RANK = 64
RW_A_RANK = 64
RW_GATE_RANK = 128
RW_DECAY_SCALE = 0.6065306597

LRU_WIDTH = D_MODEL // 4
LRU_BLOCKS = 8
LRU_BLOCK = LRU_WIDTH // LRU_BLOCKS
LRU_CONV = 4
LRU_PAD_L = 2
LRU_C = 8.0

GLA_HEADS = 4
GLA_V = D_MODEL // 4
GLA_QK = GLA_V // 2
GLA_DK = GLA_QK // GLA_HEADS
GLA_DV = GLA_V // GLA_HEADS
GLA_RANK = 16
GLA_TAU = 16.0

ML_HEADS = 4
ML_WIDTH = D_MODEL // 4
ML_DH = ML_WIDTH // ML_HEADS

IN_LAYOUT = (
    ("rw_r", RW_WIDTH), ("rw_k", RW_WIDTH), ("rw_v", RW_WIDTH),
    ("rw_w", 2 * RW_DECAY_RANK), ("rw_a", 2 * RW_A_RANK), ("rw_g", RW_GATE_RANK),
    ("lru_x", LRU_WIDTH), ("lru_g", LRU_WIDTH),
    ("gla_q", GLA_QK), ("gla_k", GLA_QK), ("gla_v", GLA_V), ("gla_r", GLA_V), ("gla_w", 2 * GLA_RANK),
    ("ml_q", ML_WIDTH), ("ml_k", ML_WIDTH), ("ml_v", ML_WIDTH), ("ml_o", ML_WIDTH),
    ("ml_i", 2 * ML_HEADS), ("ml_f", 2 * ML_HEADS),
)
IN_COLS = sum(s for _, s in IN_LAYOUT)

kernel_name = "bidir_hybrid_rwkv7_rglru_gla_mlstm_prefix_trunk"

F32 = jnp.float32


def _rmsnorm(x, w):
    xf = x.astype(F32)
    y = xf * lax.rsqrt(jnp.mean(xf * xf, axis=-1, keepdims=True) + EPS)
    return (y * w.astype(F32)).astype(x.dtype)


def _head_rmsnorm(y, w, n_heads):
    shp = y.shape
    yh = y.reshape(shp[:-1] + (n_heads, shp[-1] // n_heads))
    yh = yh * lax.rsqrt(jnp.mean(yh * yh, axis=-1, keepdims=True) + EPS)
    return yh.reshape(shp) * w.astype(F32)


def _modulate(x, w, shift, scale):
    return _rmsnorm(x, w) * (1 + scale) + shift


def _split_cols(u):
    sizes = [s for _, s in IN_LAYOUT]
    idx = np.cumsum(sizes)[:-1].tolist()
    parts = jnp.split(u, idx, axis=-1)
    return dict(zip([n for n, _ in IN_LAYOUT], parts))


def _bidir(u):
    return jnp.stack([u, jnp.flip(u, axis=1)], axis=0)


def _flip_bwd(u2):
    return jnp.stack([u2[0], jnp.flip(u2[1], axis=1)], axis=0)


def _unbidir_sum(y2):
    return y2[0] + jnp.flip(y2[1], axis=1)


def _to_col_major(u, rows):
    b, l, ch = u.shape
    return jnp.swapaxes(u.reshape(b, rows, GRID_W, ch), 1, 2).reshape(b, l, ch)


def _to_row_major(u, rows):
    b, l, ch = u.shape
    return jnp.swapaxes(u.reshape(b, GRID_W, rows, ch), 1, 2).reshape(b, l, ch)


def _chunks(t):
    z, b, l = t.shape[:3]
    t = t.reshape((z, b, l // CHUNK, CHUNK) + t.shape[3:])
    return jnp.moveaxis(t, 2, 0)


def _unchunks(t):
    t = jnp.moveaxis(t, 0, 2)
    return t.reshape(t.shape[:2] + (-1,) + t.shape[4:])


def _rwkv7_mixer(cols, w_up, w0, a_up, a0, g_up, k_k, k_a, r_k, ln_w, s0):
    r = cols["rw_r"].astype(F32)
    k = cols["rw_k"].astype(F32)
    v = cols["rw_v"].astype(F32)
    b, l, _ = r.shape
    wd = cols["rw_w"].astype(F32).reshape(b, l, 2, RW_DECAY_RANK)
    ad = cols["rw_a"].astype(F32).reshape(b, l, 2, RW_A_RANK)
    decay = jnp.exp(-RW_DECAY_SCALE * jax.nn.sigmoid(
        jnp.einsum("blzr,zrc->zblc", jnp.tanh(wd), w_up) + w0[:, None, None, :]))
    a = jax.nn.sigmoid(jnp.einsum("blzr,zrc->zblc", ad, a_up) + a0[:, None, None, :])
    kk = (k * k_k).reshape(b, l, RW_HEADS, RW_HEAD)
    kk = kk / jnp.maximum(jnp.sqrt(jnp.sum(kk * kk, axis=-1, keepdims=True)), 1e-12)
    kk = kk.reshape(b, l, RW_WIDTH)
    kd = k[None] * (1 + (a - 1) * k_a)
    kk2 = _bidir(kk)

    def heads(t):
        return jnp.moveaxis(t.reshape(2, b, l, RW_HEADS, RW_HEAD), 2, 0)

    xs = (heads(_bidir(r)), heads(_flip_bwd(decay)), heads(_flip_bwd(kd)), heads(_bidir(v)),
          heads(kk2), heads(kk2 * _flip_bwd(a)))

    def step(S, inp):
        rt, wt, kt, vt, kkt, bt = inp
        sa = jnp.einsum("zbhvk,zbhk->zbhv", S, -kkt)
        S = S * wt[..., None, :] + sa[..., :, None] * bt[..., None, :] + vt[..., :, None] * kt[..., None, :]
        return S, jnp.einsum("zbhvk,zbhk->zbhv", S, rt)

    s_fin, y2 = lax.scan(step, s0, xs)
    y2 = jnp.moveaxis(y2, 0, 2).reshape(2, b, l, RW_WIDTH)
    y = _head_rmsnorm(_unbidir_sum(y2), ln_w, RW_HEADS)
    bonus = jnp.sum((r * k * r_k).reshape(b, l, RW_HEADS, RW_HEAD), axis=-1, keepdims=True) \
        * v.reshape(b, l, RW_HEADS, RW_HEAD)
    g = jax.nn.sigmoid(cols["rw_g"].astype(F32)) @ g_up
    return (y + bonus.reshape(b, l, RW_WIDTH)) * g, s_fin


def _rglru_mixer(cols, conv_w, conv_b, w_a, b_a, w_x, b_x, lam, h0, rows):
    xb = cols["lru_x"].astype(F32)
    gb = cols["lru_g"].astype(F32)
    b, l, ch = xb.shape
    if rows is not None:
        xb = _to_col_major(xb, rows)
    xp = jnp.pad(xb, ((0, 0), (LRU_PAD_L, LRU_CONV - 1 - LRU_PAD_L), (0, 0)))
    xc = conv_b.astype(F32)
    for j in range(LRU_CONV):
        xc = xc + xp[:, j:j + l] * conv_w[j]
    xblk = xc.reshape(b, l, LRU_BLOCKS, LRU_BLOCK)
    rg = jax.nn.sigmoid(jnp.einsum("blnc,zncj->zblnj", xblk, w_a).reshape(2, b, l, ch) + b_a[:, None, None, :])
    ig = jax.nn.sigmoid(jnp.einsum("blnc,zncj->zblnj", xblk, w_x).reshape(2, b, l, ch) + b_x[:, None, None, :])
    log_a = -LRU_C * rg * jax.nn.softplus(-lam)[:, None, None, :]
    a = jnp.exp(log_a)
    bterm = jnp.sqrt(-jnp.expm1(2.0 * log_a)) * ig * xc[None]
    a2 = _flip_bwd(a)
    b2 = _flip_bwd(bterm)

    def combine(p, q):
        return (p[0] * q[0], q[0] * p[1] + q[1])

    a_cum, b_cum = lax.associative_scan(combine, (a2, b2), axis=2)
    h = a_cum * h0[:, :, None, :] + b_cum
    h_fin = h[:, :, -1]
    y = _unbidir_sum(h)
    if rows is not None:
        y = _to_row_major(y, rows)
    return y * jax.nn.gelu(gb), h_fin


def _gla_chunked(q, k, v, la, s0):
    tri = jnp.tril(jnp.ones((CHUNK, CHUNK), dtype=bool))

    def step(S, inp):
        qc, kc, vc, lac = inp
        bcum = jnp.cumsum(lac, axis=2)
        b_end = bcum[:, :, -1]
        qe = qc * jnp.exp(bcum)
        att = jnp.einsum("zbthd,zbshd->zbhts", qe, kc * jnp.exp(-bcum))
        att = jnp.where(tri, att, 0.0)
        o = jnp.einsum("zbhts,zbshv->zbthv", att, vc) + jnp.einsum("zbthd,zbhdv->zbthv", qe, S)
        S = jnp.exp(b_end)[..., None] * S + jnp.einsum(
            "zbshd,zbshv->zbhdv", kc * jnp.exp(b_end[:, :, None] - bcum), vc)
        return S, o

    s_fin, o = lax.scan(step, s0, (_chunks(q), _chunks(k), _chunks(v), _chunks(la)))
    return _unchunks(o), s_fin


def _gla_mixer(cols, w_up, w0, ln_w, s0):
    q = cols["gla_q"].astype(F32) * GLA_DK ** -0.5
    k = cols["gla_k"].astype(F32)
    v = cols["gla_v"].astype(F32)
    r = cols["gla_r"].astype(F32)
    b, l, _ = q.shape
    wd = cols["gla_w"].astype(F32).reshape(b, l, 2, GLA_RANK)
    la = jax.nn.log_sigmoid(jnp.einsum("blzr,zrc->zblc", wd, w_up) + w0[:, None, None, :]) / GLA_TAU
    q2 = _bidir(q).reshape(2, b, l, GLA_HEADS, GLA_DK)
    k2 = _bidir(k).reshape(2, b, l, GLA_HEADS, GLA_DK)
    v2 = _bidir(v).reshape(2, b, l, GLA_HEADS, GLA_DV)
    la2 = _flip_bwd(la).reshape(2, b, l, GLA_HEADS, GLA_DK)
    o2, s_fin = _gla_chunked(q2, k2, v2, la2, s0)
    y = _head_rmsnorm(_unbidir_sum(o2).reshape(b, l, GLA_V), ln_w, GLA_HEADS)
    return y * jax.nn.silu(r), s_fin


def _mlstm_chunked(q, k, v, ig, lf, state0):
    tri = jnp.tril(jnp.ones((CHUNK, CHUNK), dtype=bool))

    def step(carry, inp):
        cm, n, m = carry
        qc, kc, vc, ic, fc = inp
        fcum = jnp.moveaxis(jnp.cumsum(fc, axis=2), 2, -1)
        ic = jnp.moveaxis(ic, 2, -1)
        f_end = fcum[..., -1]
        dlog = fcum[..., :, None] - fcum[..., None, :] + ic[..., None, :]
        dlog = jnp.where(tri, dlog, NEG)
        inter = fcum + m[..., None]
        mt = jnp.maximum(inter, jnp.max(dlog, axis=-1))
        w = jnp.exp(dlog - mt[..., None]) * jnp.einsum("zbthd,zbshd->zbhts", qc, kc)
        ei = jnp.exp(inter - mt)
        num = jnp.einsum("zbhts,zbshv->zbhtv", w, vc) + ei[..., None] * jnp.einsum("zbhvd,zbthd->zbhtv", cm, qc)
        den = jnp.sum(w, axis=-1) + ei * jnp.einsum("zbhd,zbthd->zbht", n, qc)
        h = num / jnp.maximum(jnp.abs(den), jnp.exp(-mt))[..., None]
        g = f_end[..., None] - fcum + ic
        m_new = jnp.maximum(f_end + m, jnp.max(g, axis=-1))
        dec = jnp.exp(f_end + m - m_new)
        wg = jnp.exp(g - m_new[..., None])
        cm = dec[..., None, None] * cm + jnp.einsum("zbhs,zbshv,zbshd->zbhvd", wg, vc, kc)
        n = dec[..., None] * n + jnp.einsum("zbhs,zbshd->zbhd", wg, kc)
        return (cm, n, m_new), jnp.moveaxis(h, 3, 2)

    st, h = lax.scan(step, state0, (_chunks(q), _chunks(k), _chunks(v), _chunks(ig), _chunks(lf)))
    return _unchunks(h), st


def _mlstm_mixer(cols, i_b, f_b, ln_w, st0):
    q = cols["ml_q"].astype(F32)
    k = cols["ml_k"].astype(F32) * ML_DH ** -0.5
    v = cols["ml_v"].astype(F32)
    o = cols["ml_o"].astype(F32)
    b, l, _ = q.shape
    ig = jnp.moveaxis(cols["ml_i"].astype(F32).reshape(b, l, 2, ML_HEADS) + i_b, 2, 0)
    lf = jnp.moveaxis(jax.nn.log_sigmoid(cols["ml_f"].astype(F32).reshape(b, l, 2, ML_HEADS) + f_b), 2, 0)
    q2 = _bidir(q).reshape(2, b, l, ML_HEADS, ML_DH)
    k2 = _bidir(k).reshape(2, b, l, ML_HEADS, ML_DH)
    v2 = _bidir(v).reshape(2, b, l, ML_HEADS, ML_DH)
    h2, st = _mlstm_chunked(q2, k2, v2, _flip_bwd(ig), _flip_bwd(lf), st0)
    y = _head_rmsnorm(_unbidir_sum(h2).reshape(b, l, ML_WIDTH), ln_w, ML_HEADS)
    return y * jax.nn.sigmoid(o), st


def _zero_states(b):
    return (jnp.zeros((2, b, RW_HEADS, RW_HEAD, RW_HEAD), F32),
            jnp.zeros((2, b, LRU_WIDTH), F32),
            jnp.zeros((2, b, GLA_HEADS, GLA_DK, GLA_DV), F32),
            (jnp.zeros((2, b, ML_HEADS, ML_DH, ML_DH), F32),
             jnp.zeros((2, b, ML_HEADS, ML_DH), F32),
             jnp.full((2, b, ML_HEADS), NEG, F32)))


def _token_mixers(u, rows, st, rw, lru, gla, ml):
    cols = _split_cols(u)
    y_a, s_a = _rwkv7_mixer(cols, *rw, st[0])
    y_b, s_b = _rglru_mixer(cols, *lru, st[1], rows)
    y_c, s_c = _gla_mixer(cols, *gla, st[2])
    y_d, s_d = _mlstm_mixer(cols, *ml, st[3])
    return (y_a, y_b, y_c, y_d), (s_a, s_b, s_c, s_d)


def _merge(h, ys, br_w, gate_w, gate_b, out_w):
    acc = jax.nn.sigmoid(h @ gate_w[0] + gate_b[0]) * (ys[0].astype(h.dtype) @ br_w[0])
    for i in range(1, N_BRANCH):
        acc = acc + jax.nn.sigmoid(h @ gate_w[i] + gate_b[i]) * (ys[i].astype(h.dtype) @ br_w[i])
    return acc @ out_w


def _sqrelu_mlp(h, w1, w2):
    return jnp.square(jax.nn.relu(h @ w1)) @ w2


def setup_inputs(seed: int = 0) -> dict:
    key = jax.random.key(seed)
    ks = iter(jax.random.split(key, 48))

    def nrm(shape, scale):
        return jax.random.normal(next(ks), shape, F32) * scale

    def gain(shape):
        return 1.0 + nrm(shape, 0.02)

    L = DEPTH
    D = D_MODEL
    u = jax.random.uniform(next(ks), (L, 2, LRU_WIDTH), F32, 0.9, 0.999)
    a_base = u ** (1.0 / LRU_C)
    lru_lambda = jnp.log(a_base) - jnp.log1p(-a_base)
    return {
        "x": nrm((BATCH, SEQ, D), 1.0),
        "c": nrm((BATCH, D), 1.0),
        "ctx": nrm((BATCH, CTX_LEN, D), 1.0),
        "c_ctx": nrm((D,), 1.0),
        "ada_w": nrm((L, D, 6 * D), 0.5 * D ** -0.5),
        "ada_b": nrm((L, 6 * D), 0.02),
        "norm_mix_w": gain((L, D)),
        "w_in": nrm((L, D, IN_COLS), D ** -0.5),
        "rw_w_up": nrm((L, 2, RW_DECAY_RANK, RW_WIDTH), RW_DECAY_RANK ** -0.5),
        "rw_w0": nrm((L, 2, RW_WIDTH), 1.5) - 1.0,
        "rw_a_up": nrm((L, 2, RW_A_RANK, RW_WIDTH), RW_A_RANK ** -0.5),
        "rw_a0": nrm((L, 2, RW_WIDTH), 0.1),
        "rw_g_up": nrm((L, RW_GATE_RANK, RW_WIDTH), RW_GATE_RANK ** -0.5),
        "rw_k_k": 0.85 + nrm((L, RW_WIDTH), 0.02),
        "rw_k_a": gain((L, RW_WIDTH)),
        "rw_r_k": nrm((L, RW_WIDTH), 0.1),
        "rw_ln_w": gain((L, RW_WIDTH)),
        "lru_conv_w": nrm((L, LRU_CONV, LRU_WIDTH), LRU_CONV ** -0.5),
        "lru_conv_b": nrm((L, LRU_WIDTH), 0.02),
        "lru_w_a": nrm((L, 2, LRU_BLOCKS, LRU_BLOCK, LRU_BLOCK), LRU_BLOCK ** -0.5),
        "lru_b_a": nrm((L, 2, LRU_WIDTH), 0.02),
        "lru_w_x": nrm((L, 2, LRU_BLOCKS, LRU_BLOCK, LRU_BLOCK), LRU_BLOCK ** -0.5),
        "lru_b_x": nrm((L, 2, LRU_WIDTH), 0.02),
        "lru_lambda": lru_lambda,
        "gla_w_up": nrm((L, 2, GLA_RANK, GLA_QK), GLA_RANK ** -0.5),
        "gla_w0": nrm((L, 2, GLA_QK), 0.5) + 2.0,
        "gla_ln_w": gain((L, GLA_V)),
        "ml_i_b": nrm((L, 2, ML_HEADS), 0.1),
        "ml_f_b": jnp.linspace(3.0, 6.0, ML_HEADS, dtype=F32)[None, None, :] + nrm((L, 2, ML_HEADS), 0.1),
        "ml_ln_w": gain((L, ML_WIDTH)),
        "br_w": nrm((L, N_BRANCH, RW_WIDTH, D), RW_WIDTH ** -0.5),
        "gate_w": nrm((L, N_BRANCH, D, D), D ** -0.5),
        "gate_b": nrm((L, N_BRANCH, D), 0.02),
        "out_w": nrm((L, D, D), D ** -0.5),
        "norm_ffn_w": gain((L, D)),
        "ffn_w1": nrm((L, D, D_FF), D ** -0.5),
        "ffn_w2": nrm((L, D_FF, D), D_FF ** -0.5),
        "final_norm_w": gain((D,)),
    }


def reference(x, c, ctx, c_ctx, ada_w, ada_b, norm_mix_w, w_in, rw_w_up, rw_w0, rw_a_up, rw_a0, rw_g_up,
              rw_k_k, rw_k_a, rw_r_k, rw_ln_w, lru_conv_w, lru_conv_b, lru_w_a, lru_b_a, lru_w_x, lru_b_x,
              lru_lambda, gla_w_up, gla_w0, gla_ln_w, ml_i_b, ml_f_b, ml_ln_w, br_w, gate_w, gate_b, out_w,
              norm_ffn_w, ffn_w1, ffn_w2, final_norm_w):
    rows = x.shape[1] // GRID_W
    n_ctx = ctx.shape[0]
    for l in range(DEPTH):
        mod_x = (jax.nn.silu(c) @ ada_w[l] + ada_b[l])[:, None, :]
        mod_c = (jax.nn.silu(c_ctx) @ ada_w[l] + ada_b[l])[None, None, :]
        sh1, sc1, g1, sh2, sc2, g2 = jnp.split(mod_x, 6, axis=-1)
        csh1, csc1, cg1, csh2, csc2, cg2 = jnp.split(mod_c, 6, axis=-1)
        rw = (rw_w_up[l], rw_w0[l], rw_a_up[l], rw_a0[l], rw_g_up[l], rw_k_k[l], rw_k_a[l], rw_r_k[l], rw_ln_w[l])
        lru = (lru_conv_w[l], lru_conv_b[l], lru_w_a[l], lru_b_a[l], lru_w_x[l], lru_b_x[l], lru_lambda[l])
        gla = (gla_w_up[l], gla_w0[l], gla_ln_w[l])
        ml = (ml_i_b[l], ml_f_b[l], ml_ln_w[l])
        hc = _modulate(ctx, norm_mix_w[l], csh1, csc1)
        ys_c, st_c = _token_mixers(hc @ w_in[l], None, _zero_states(n_ctx), rw, lru, gla, ml)
        hx = _modulate(x, norm_mix_w[l], sh1, sc1)
        ys_x, _ = _token_mixers(hx @ w_in[l], rows, st_c, rw, lru, gla, ml)
        x = x + g1 * _merge(hx, ys_x, br_w[l], gate_w[l], gate_b[l], out_w[l])
        x = x + g2 * _sqrelu_mlp(_modulate(x, norm_ffn_w[l], sh2, sc2), ffn_w1[l], ffn_w2[l])
        if l < DEPTH - 1:
            ctx = ctx + cg1 * _merge(hc, ys_c, br_w[l], gate_w[l], gate_b[l], out_w[l])
            ctx = ctx + cg2 * _sqrelu_mlp(_modulate(ctx, norm_ffn_w[l], csh2, csc2), ffn_w1[l], ffn_w2[l])
    return _rmsnorm(x, final_norm_w)
```

```cpp
#include <hip/hip_runtime.h>
#include <hip/hip_cooperative_groups.h>
#include <cstdio>
namespace cg = cooperative_groups;

#define LAS __attribute__((address_space(3)))
typedef unsigned short bf16_t;
typedef short bf16x8 __attribute__((ext_vector_type(8)));
typedef float f32x4 __attribute__((ext_vector_type(4)));
typedef float f32x2 __attribute__((ext_vector_type(2)));
typedef unsigned u32x4 __attribute__((ext_vector_type(4)));
typedef unsigned u32x2 __attribute__((ext_vector_type(2)));

constexpr int D = 2048, SEQ = 8192, CTX = 256, DFF = 8192;
constexpr int ML = 2 * SEQ;
constexpr int MC = 2 * CTX;
constexpr int MT = ML + MC;
constexpr int INC = 6576, INP = 6656;
constexpr int C_RW_R = 0, C_RW_K = 512, C_RW_V = 1024, C_RW_W = 1536, C_RW_A = 1664, C_RW_G = 1792, C_LRU_X = 1920, C_LRU_G = 2432,
              C_GLA_Q = 2944, C_GLA_K = 3200, C_GLA_V = 3456, C_GLA_R = 3968, C_GLA_W = 4480, C_ML_Q = 4512, C_ML_K = 5024, C_ML_V = 5536,
              C_ML_O = 6048, C_ML_I = 6560, C_ML_F = 6568;
constexpr float EPS = 1e-6f;
constexpr int LDS_BYTES = 147456;
constexpr int NCH = 264;

constexpr size_t AL(size_t x) { return (x + 255) & ~(size_t)255; }
constexpr size_t OFF_MOD = 0;
constexpr size_t OFF_WIN = AL(OFF_MOD + (size_t)2 * 3 * 12288 * 4);
constexpr size_t OFF_WGT = OFF_WIN + (size_t)INP * 2048 * 2;
constexpr size_t OFF_WBR = OFF_WGT + (size_t)8192 * 2048 * 2;
constexpr size_t OFF_WOUT = OFF_WBR + (size_t)4 * 2048 * 512 * 2;
constexpr size_t OFF_W1 = OFF_WOUT + (size_t)2048 * 2048 * 2;
constexpr size_t OFF_W2 = OFF_W1 + (size_t)8192 * 2048 * 2;
constexpr size_t OFF_XB = OFF_W2 + (size_t)2048 * 8192 * 2;
constexpr size_t OFF_HX = OFF_XB + (size_t)MT * 2048 * 4;
constexpr size_t OFF_BIG = OFF_HX + (size_t)MT * 2048 * 2;
constexpr size_t OFF_U = OFF_BIG;
constexpr size_t SZ_Y = (size_t)2 * MT * 512 * 2;
constexpr size_t OFF_YRW = OFF_U + (size_t)MT * INP * 2;
constexpr size_t OFF_YGL = OFF_YRW + SZ_Y;
constexpr size_t OFF_YML = OFF_YGL + SZ_Y;
constexpr size_t OFF_DEN = OFF_YML + SZ_Y;
constexpr size_t OFF_PREP = AL(OFF_DEN + (size_t)2 * MT * 4 * 4);
constexpr size_t OFF_LW = OFF_PREP;
constexpr size_t OFF_AA = OFF_LW + SZ_Y;
constexpr size_t OFF_NKK = OFF_AA + SZ_Y;
constexpr size_t OFF_LA = OFF_NKK + (size_t)MT * 512 * 2;
constexpr size_t OFF_LACUM = OFF_LA + (size_t)2 * MT * 256 * 2;
constexpr size_t OFF_LHLOC = OFF_LACUM + SZ_Y;
constexpr size_t SZ_LS = (size_t)2 * 2 * NCH * 512 * 4;
constexpr size_t OFF_APROD = OFF_LHLOC + SZ_Y;
constexpr size_t OFF_HEND = OFF_APROD + SZ_LS;
constexpr size_t OFF_CARRY = OFF_HEND + SZ_LS;
constexpr size_t OFF_BAR = OFF_CARRY + SZ_LS;
constexpr size_t OFF_GV = OFF_BAR + 16384;
constexpr size_t OFF_WX1 = OFF_GV + (size_t)MT * 512 * 2;
constexpr size_t OFF_WX2 = OFF_WX1 + (size_t)2560 * 384 * 2;
constexpr size_t WS_END = OFF_WX2 + (size_t)2048 * 512 * 2;
constexpr size_t OFF_XC = OFF_YML + AL((size_t)MT * 384 * 2);
constexpr size_t OFF_GATES = OFF_YRW;
static_assert(OFF_XC + (size_t)MT * 512 * 2 <= OFF_YML + SZ_Y, "XC alias");
constexpr size_t OFF_AX1 = OFF_YML;
constexpr size_t OFF_YS = OFF_PREP;
constexpr size_t OFF_G = OFF_BIG;
constexpr size_t OFF_ACC = OFF_HX;
constexpr size_t OFF_F = OFF_BIG;
static_assert(OFF_YS + (size_t)MT * 2048 * 2 <= OFF_LACUM, "YS alias");
static_assert(OFF_G + (size_t)MT * 8192 * 2 <= OFF_PREP, "G alias");

struct Params {
    const float *x, *c, *ctx, *c_ctx, *ada_w, *ada_b, *norm_mix_w, *w_in, *rw_w_up, *rw_w0, *rw_a_up, *rw_a0, *rw_g_up, *rw_k_k, *rw_k_a, *rw_r_k, *rw_ln_w,
        *lru_conv_w, *lru_conv_b, *lru_w_a, *lru_b_a, *lru_w_x, *lru_b_x, *lru_lambda, *gla_w_up, *gla_w0, *gla_ln_w, *ml_i_b, *ml_f_b, *ml_ln_w,
        *br_w, *gate_w, *gate_b, *out_w, *norm_ffn_w, *ffn_w1, *ffn_w2, *final_norm_w;
    float* out;
    unsigned char* ws;
};

__device__ __forceinline__ int otid() { int t = threadIdx.x; asm volatile("" : "+v"(t)); return t; }
__device__ __forceinline__ float bf2f(bf16_t v) { return __uint_as_float(((unsigned)v) << 16); }
__device__ __forceinline__ unsigned cvt_pk_bf16(float lo, float hi) { unsigned r; asm("v_cvt_pk_bf16_f32 %0, %1, %2" : "=v"(r) : "v"(lo), "v"(hi)); return r; }
__device__ __forceinline__ bf16_t f2bf(float x) { return (bf16_t)(cvt_pk_bf16(x, 0.f) & 0xffffu); }
__device__ __forceinline__ float rcp_(float d) { float r; asm volatile("s_nop 1\n\tv_rcp_f32 %0, %1\n\ts_nop 1" : "=&v"(r) : "v"(d)); return r; }
__device__ __forceinline__ float sigm(float x) { return rcp_(1.0f + __expf(-x)); }
__device__ __forceinline__ float tanh_(float x) { const float t = __expf(2.0f * x); return 1.0f - 2.0f * rcp_(t + 1.0f); }
__device__ __forceinline__ float gelu_tanh(float x) { return 0.5f * x * (1.0f + tanh_(0.7978845608028654f * (x + 0.044715f * x * x * x))); }
__device__ __forceinline__ float log_sigm(float x) { return fminf(x, 0.f) - log1pf(__expf(-fabsf(x))); }
__device__ __forceinline__ float softplus_(float y) { return fmaxf(y, 0.f) + log1pf(__expf(-fabsf(y))); }
template <int CTRL> __device__ __forceinline__ float dppmov(float x) { return __int_as_float(__builtin_amdgcn_update_dpp(0, __float_as_int(x), CTRL, 0xF, 0xF, true)); }
__device__ __forceinline__ float red16(float x) {
    x += dppmov<0xB1>(x); x += dppmov<0x4E>(x); x += dppmov<0x141>(x); x += dppmov<0x140>(x); return x;
}
__device__ __forceinline__ float red8(float x) { x += dppmov<0xB1>(x); x += dppmov<0x4E>(x); x += dppmov<0x141>(x); return x; }
__device__ __forceinline__ float wave_sum(float v) {
    v = red16(v);
    const float a = __int_as_float(__builtin_amdgcn_readlane(__float_as_int(v), 0)), b = __int_as_float(__builtin_amdgcn_readlane(__float_as_int(v), 16)),
                c = __int_as_float(__builtin_amdgcn_readlane(__float_as_int(v), 32)), d = __int_as_float(__builtin_amdgcn_readlane(__float_as_int(v), 48));
    return (a + b) + (c + d);
}
__device__ __forceinline__ void unpack4(const u32x2 w, float (&f)[4]) { f[0] = __uint_as_float(w.x << 16); f[1] = __uint_as_float(w.x & 0xffff0000u); f[2] = __uint_as_float(w.y << 16); f[3] = __uint_as_float(w.y & 0xffff0000u); }
__device__ __forceinline__ void unpack8(const u32x4 w, float (&f)[8]) {
    f[0] = __uint_as_float(w.x << 16); f[1] = __uint_as_float(w.x & 0xffff0000u); f[2] = __uint_as_float(w.y << 16); f[3] = __uint_as_float(w.y & 0xffff0000u);
    f[4] = __uint_as_float(w.z << 16); f[5] = __uint_as_float(w.z & 0xffff0000u); f[6] = __uint_as_float(w.w << 16); f[7] = __uint_as_float(w.w & 0xffff0000u);
}
__device__ __forceinline__ u32x4 pack8(const float (&f)[8]) { u32x4 w; w.x = cvt_pk_bf16(f[0], f[1]); w.y = cvt_pk_bf16(f[2], f[3]); w.z = cvt_pk_bf16(f[4], f[5]); w.w = cvt_pk_bf16(f[6], f[7]); return w; }

namespace pg8 {
constexpr int BM = 256, BK = 64, HALF = 128, HTB = HALF * BK * 2, STAGE_BYTES = 8 * HTB, NXCD = 8, WGM = 8;
__device__ __forceinline__ int lds_byte(int r, int c) { const int st = (r >> 4) * 2 + (c >> 5), rr = r & 15, cc = c & 31, ob = rr * 64 + cc * 2; return st * 1024 + (ob ^ (((ob >> 9) & 1) << 5)); }
__device__ __forceinline__ void stage_rc(int b, int& R, int& C) { const int st = b / 1024, sb = b % 1024, swz = sb ^ (((sb >> 9) & 1) << 5); R = (st >> 1) * 16 + swz / 64; C = (st & 1) * 32 + (swz % 64) / 2; }
__device__ __forceinline__ int perm32(int rho) { const int n = rho >> 4, i = rho & 15; return 8 * (i >> 2) + 4 * n + (i & 3); }

struct Unit { int pm, pn, pb, ak, br, bk; };
struct Gemm { const bf16_t* A; const bf16_t* Bt; int M, N, K, lda, ldb; };
struct Sched {
    int nM, nN, nwg, G, c, grp, split, pm0, ksub;
    __device__ void init(int M, int N, int G_, int c_, int grp_) { nM = M / BM; nN = N / BM; nwg = nM * nN; G = G_; c = c_; grp = grp_; split = 0; pm0 = 0; ksub = 0; }
    __device__ void init_split(int pm0_, int nMt, int N, int S, int ksub_, int G_, int c_) { nM = nMt; nN = N / BM; nwg = nMt * nN * S; G = G_; c = c_; grp = 1; split = S; pm0 = pm0_; ksub = ksub_; }
    __device__ bool next(int i, Unit& u) const {
        const int q = (grp == 4) ? (i >> 2) : i, br = (grp == 4) ? (i & 3) : 0;
        const long L = (long)q * G + c; if (L >= nwg) return false;
        if (split) { const int ks = (int)L % split, tile = (int)L / split; u.pm = pm0 + tile / nN; u.pn = tile % nN; u.pb = u.pn; u.ak = ks * ksub; u.bk = u.ak; u.br = 0; return true; }
        int wgid = (int)L; { const int qq = nwg / NXCD, r = nwg % NXCD, xcd = wgid % NXCD, off = wgid / NXCD; wgid = (xcd < r ? xcd * (qq + 1) : r * (qq + 1) + (xcd - r) * qq) + off; }
        const int nig = WGM * nN, gid = wgid / nig, fm = gid * WGM, gsz = (nM - fm) < WGM ? (nM - fm) : WGM;
        u.pm = fm + ((wgid % nig) % gsz); u.pn = (wgid % nig) / gsz; u.br = br; u.pb = br * nN + u.pn; u.ak = br * 512; u.bk = 0; return true;
    }
};

template <class Epi>
__device__ __forceinline__ void gemm_phase(LAS unsigned char* lds, const Gemm g, const Sched& S, const Epi& E) {
    const int tid = otid(), wid = __builtin_amdgcn_readfirstlane(tid >> 6), lane = tid & 63, wr = wid >> 2, wc = wid & 3, fr = lane & 15, fq = lane >> 4;
    int nt = g.K / BK; asm volatile("" : "+s"(nt));
    unsigned voffA[2], voffB[2];
#pragma unroll
    for (int i = 0; i < 2; ++i) { int R, C; stage_rc(tid * 16 + i * 8192, R, C); const int Rb = Epi::PERM ? ((R & ~31) + perm32(R & 31)) : R;
        voffA[i] = (unsigned)(R * g.lda + C) * 2u; voffB[i] = (unsigned)(Rb * g.ldb + C) * 2u; }
    const size_t kstep = (size_t)(BK * 2);
    const size_t hstepA = (size_t)HALF * g.lda * 2, hstepB = (size_t)HALF * g.ldb * 2;
    const unsigned ldsw = (unsigned)wid * 1024u;
    const int aoff = lds_byte(wr * 64 + fr, fq * 8), boff = lds_byte(wc * 32 + fr, fq * 8);
#define PG8_SA(b, h) (((b) * 2 + (h)) * HTB)
#define PG8_SB(b, h) ((4 + (b) * 2 + (h)) * HTB)
#define PG8_STAGE(bufoff, gbase, voff) do { _Pragma("unroll") for (int _i = 0; _i < 2; ++_i) \
        __builtin_amdgcn_global_load_lds((const unsigned*)((const char*)(gbase) + (voff)[_i]), (LAS unsigned*)(lds + (bufoff) + ldsw + _i * 8192), 16, 0, 0); } while (0)
#define PG8_LDA(dst, b, h) do { _Pragma("unroll") for (int m = 0; m < 4; ++m) _Pragma("unroll") for (int k = 0; k < 2; ++k) dst[m][k] = *(const LAS bf16x8*)(lds + PG8_SA(b, h) + aoff + m * 2048 + k * 1024); } while (0)
#define PG8_LDB(dst, b, h) do { _Pragma("unroll") for (int n = 0; n < 2; ++n) _Pragma("unroll") for (int k = 0; k < 2; ++k) dst[n][k] = *(const LAS bf16x8*)(lds + PG8_SB(b, h) + boff + n * 2048 + k * 1024); } while (0)
#define PG8_MMA(ai, bj, At, Bt) do { __builtin_amdgcn_s_setprio(1); _Pragma("unroll") for (int m = 0; m < 4; ++m) _Pragma("unroll") for (int n = 0; n < 2; ++n) _Pragma("unroll") for (int k = 0; k < 2; ++k) \
        acc[ai][bj][m][n] = __builtin_amdgcn_mfma_f32_16x16x32_bf16(Bt[n][k], At[m][k], acc[ai][bj][m][n], 0, 0, 0); __builtin_amdgcn_s_setprio(0); } while (0)
#define PG8_WAIT_V(n) asm volatile("s_waitcnt vmcnt(" #n ")" ::: "memory")
#define PG8_WAIT_L(n) asm volatile("s_waitcnt lgkmcnt(" #n ")" ::: "memory")
#define PG8_BAR __builtin_amdgcn_s_barrier()
#define PG8_SCHED __builtin_amdgcn_sched_barrier(0)
    Unit cur, nxt; int ui = 0;
    if (!S.next(0, cur)) return;
    f32x4 acc[2][2][4][2];
#pragma unroll
    for (int a = 0; a < 2; ++a)
#pragma unroll
        for (int b = 0; b < 2; ++b)
#pragma unroll
            for (int m = 0; m < 4; ++m)
#pragma unroll
                for (int n = 0; n < 2; ++n) acc[a][b][m][n] = (f32x4){0.f, 0.f, 0.f, 0.f};
    bf16x8 At[4][2], B0[2][2], B1[2][2];
    const char* cA = (const char*)g.A + (size_t)cur.pm * 2 * hstepA + (size_t)cur.ak * 2;
    const char* cB = (const char*)g.Bt + (size_t)cur.pb * 2 * hstepB + (size_t)cur.bk * 2;
    PG8_STAGE(PG8_SB(0, 0), cB, voffB); PG8_STAGE(PG8_SA(0, 0), cA, voffA); PG8_STAGE(PG8_SB(0, 1), cB + hstepB, voffB); PG8_STAGE(PG8_SA(0, 1), cA + hstepA, voffA);
    if (wr == 1) PG8_BAR;
    PG8_WAIT_V(4); PG8_BAR;
    PG8_STAGE(PG8_SB(1, 0), cB + kstep, voffB); PG8_STAGE(PG8_SA(1, 0), cA + kstep, voffA); PG8_STAGE(PG8_SB(1, 1), cB + hstepB + kstep, voffB);
    PG8_WAIT_V(6); PG8_BAR;
    for (;;) {
        const bool has_next = S.next(ui + 1, nxt);
        const char* nA = has_next ? (const char*)g.A + (size_t)nxt.pm * 2 * hstepA + (size_t)nxt.ak * 2 : cA;
        const char* nB = has_next ? (const char*)g.Bt + (size_t)nxt.pb * 2 * hstepB + (size_t)nxt.bk * 2 : cB;
        for (int t = 0; t < nt; t += 2) {
            const bool last = (t == nt - 2);
            const char* a1 = cA + (size_t)(t + 1) * kstep;
            const char* a2 = last ? nA : cA + (size_t)(t + 2) * kstep; const char* b2 = last ? nB : cB + (size_t)(t + 2) * kstep;
            const char* a3 = a2 + kstep; const char* b3 = b2 + kstep;
            PG8_LDB(B0, 0, 0); PG8_SCHED; PG8_LDA(At, 0, 0); PG8_STAGE(PG8_SA(1, 1), a1 + hstepA, voffA);
            PG8_WAIT_L(8); PG8_BAR; PG8_WAIT_L(0); PG8_MMA(0, 0, At, B0); PG8_BAR; PG8_SCHED;
            PG8_LDB(B1, 0, 1); PG8_STAGE(PG8_SB(0, 0), b2, voffB);
            PG8_BAR; PG8_WAIT_L(0); PG8_MMA(0, 1, At, B1); PG8_BAR;
            PG8_LDA(At, 0, 1); PG8_STAGE(PG8_SA(0, 0), a2, voffA);
            PG8_BAR; PG8_WAIT_L(0); PG8_MMA(1, 0, At, B0); PG8_BAR; PG8_SCHED;
            PG8_STAGE(PG8_SB(0, 1), b2 + hstepB, voffB);
            PG8_WAIT_V(6); PG8_BAR; PG8_MMA(1, 1, At, B1); PG8_BAR;
            PG8_LDB(B0, 1, 0); PG8_SCHED; PG8_LDA(At, 1, 0); PG8_STAGE(PG8_SA(0, 1), a2 + hstepA, voffA);
            PG8_WAIT_L(8); PG8_BAR; PG8_WAIT_L(0); PG8_MMA(0, 0, At, B0); PG8_BAR; PG8_SCHED;
            PG8_LDB(B1, 1, 1); PG8_STAGE(PG8_SB(1, 0), b3, voffB);
            PG8_BAR; PG8_WAIT_L(0); PG8_MMA(0, 1, At, B1); PG8_BAR;
            PG8_LDA(At, 1, 1); PG8_STAGE(PG8_SA(1, 0), a3, voffA);
            PG8_BAR; PG8_WAIT_L(0); PG8_MMA(1, 0, At, B0); PG8_BAR; PG8_SCHED;
            PG8_STAGE(PG8_SB(1, 1), b3 + hstepB, voffB);
            PG8_WAIT_V(6); PG8_BAR; PG8_MMA(1, 1, At, B1); PG8_BAR;
        }
        const bool keep = E(acc, cur, wr, wc, fr, fq);
        if (!has_next) break;
        if (!keep) {
#pragma unroll
            for (int a = 0; a < 2; ++a)
#pragma unroll
                for (int b = 0; b < 2; ++b)
#pragma unroll
                    for (int m = 0; m < 4; ++m)
#pragma unroll
                        for (int n = 0; n < 2; ++n) acc[a][b][m][n] = (f32x4){0.f, 0.f, 0.f, 0.f};
        }
        cur = nxt; cA = nA; cB = nB; ++ui;
    }
    PG8_WAIT_V(0);
    if (wr == 0) PG8_BAR;
    PG8_BAR;
#undef PG8_SA
#undef PG8_SB
#undef PG8_STAGE
#undef PG8_LDA
#undef PG8_LDB
#undef PG8_MMA
#undef PG8_WAIT_V
#undef PG8_WAIT_L
#undef PG8_BAR
#undef PG8_SCHED
}

template <int ACT  , int ldc> struct EpiB16 {
    static constexpr bool PERM = true;
    bf16_t* O; const float* bias;
    __device__ __forceinline__ bool operator()(f32x4 (&acc)[2][2][4][2], const Unit& u, int wr, int wc, int fr, int fq) const {
        const int row0 = u.pm * BM + wr * 64 + fr, col0 = u.pn * BM + wc * 32 + 8 * fq;
        f32x4 bv[2][2];
#pragma unroll
        for (int bj = 0; bj < 2; ++bj)
#pragma unroll
            for (int n = 0; n < 2; ++n) bv[bj][n] = (ACT == 1) ? *(const f32x4*)(bias + col0 + bj * HALF + 4 * n) : (f32x4){0.f, 0.f, 0.f, 0.f};
#pragma unroll
        for (int ai = 0; ai < 2; ++ai)
#pragma unroll
            for (int m = 0; m < 4; ++m) { bf16_t* rowp = O + (size_t)(row0 + ai * HALF + m * 16) * ldc + col0;
#pragma unroll
                for (int bj = 0; bj < 2; ++bj) { f32x4 v0 = acc[ai][bj][m][0], v1 = acc[ai][bj][m][1];
                    if (ACT == 1) {
                        v0 += bv[bj][0]; v1 += bv[bj][1];
#pragma unroll
                        for (int j = 0; j < 4; ++j) { v0[j] = sigm(v0[j]); v1[j] = sigm(v1[j]); } }
                    if (ACT == 2) {
#pragma unroll
                        for (int j = 0; j < 4; ++j) { const float a = fmaxf(v0[j], 0.f), b = fmaxf(v1[j], 0.f); v0[j] = a * a; v1[j] = b * b; } }
                    u32x4 w; w.x = cvt_pk_bf16(v0[0], v0[1]); w.y = cvt_pk_bf16(v0[2], v0[3]); w.z = cvt_pk_bf16(v1[0], v1[1]); w.w = cvt_pk_bf16(v1[2], v1[3]);
                    *(u32x4*)(rowp + bj * HALF) = w; } }
        return false;
    }
};
struct EpiRWX {
    static constexpr bool PERM = true;
    bf16_t* LWp; bf16_t* AAp; bf16_t* GVp; const float* w0; const float* a0;
    __device__ __forceinline__ bool operator()(f32x4 (&acc)[2][2][4][2], const Unit& u, int wr, int wc, int fr, int fq) const {
        const int row0 = u.pm * BM + wr * 64 + fr, t = u.pn >> 1, cc0 = (u.pn & 1) * 256 + wc * 32 + 8 * fq, z = t & 1;
        const float* bias = (t < 2) ? w0 + z * 512 : a0 + z * 512;
        bf16_t* base = (t < 2) ? LWp + (size_t)z * MT * 512 : ((t < 4) ? AAp + (size_t)z * MT * 512 : GVp);
        f32x4 bv[2][2];
#pragma unroll
        for (int bj = 0; bj < 2; ++bj)
#pragma unroll
            for (int n = 0; n < 2; ++n) bv[bj][n] = (t < 4) ? *(const f32x4*)(bias + cc0 + bj * HALF + 4 * n) : (f32x4){0.f, 0.f, 0.f, 0.f};
        const float sc = (t < 2) ? -0.6065306597f : 1.0f;
#pragma unroll
        for (int ai = 0; ai < 2; ++ai)
#pragma unroll
            for (int m = 0; m < 4; ++m) { bf16_t* rowp = base + (size_t)(row0 + ai * HALF + m * 16) * 512 + cc0;
#pragma unroll
                for (int bj = 0; bj < 2; ++bj) { f32x4 v0 = acc[ai][bj][m][0] + bv[bj][0], v1 = acc[ai][bj][m][1] + bv[bj][1];
                    if (t < 4) {
#pragma unroll
                        for (int j = 0; j < 4; ++j) { v0[j] = sc * sigm(v0[j]); v1[j] = sc * sigm(v1[j]); } }
                    u32x4 w; w.x = cvt_pk_bf16(v0[0], v0[1]); w.y = cvt_pk_bf16(v0[2], v0[3]); w.z = cvt_pk_bf16(v1[0], v1[1]); w.w = cvt_pk_bf16(v1[2], v1[3]);
                    *(u32x4*)(rowp + bj * HALF) = w; } }
        return false;
    }
};
struct EpiGate {
    static constexpr bool PERM = true;
    bf16_t* O; const float* ba; const float* bx;
    __device__ __forceinline__ bool operator()(f32x4 (&acc)[2][2][4][2], const Unit& u, int wr, int wc, int fr, int fq) const {
        const int row0 = u.pm * BM + wr * 64 + fr, gz = u.pn >> 1, cc0 = (u.pn & 1) * 256 + wc * 32 + 8 * fq;
        const float* bias = ((gz >> 1) ? bx : ba) + (gz & 1) * 512;
        bf16_t* base = O + (size_t)gz * MT * 512;
        f32x4 bv[2][2];
#pragma unroll
        for (int bj = 0; bj < 2; ++bj)
#pragma unroll
            for (int n = 0; n < 2; ++n) bv[bj][n] = *(const f32x4*)(bias + cc0 + bj * HALF + 4 * n);
#pragma unroll
        for (int ai = 0; ai < 2; ++ai)
#pragma unroll
            for (int m = 0; m < 4; ++m) { bf16_t* rowp = base + (size_t)(row0 + ai * HALF + m * 16) * 512 + cc0;
#pragma unroll
                for (int bj = 0; bj < 2; ++bj) { f32x4 v0 = acc[ai][bj][m][0] + bv[bj][0], v1 = acc[ai][bj][m][1] + bv[bj][1];
#pragma unroll
                    for (int j = 0; j < 4; ++j) { v0[j] = sigm(v0[j]); v1[j] = sigm(v1[j]); }
                    u32x4 w; w.x = cvt_pk_bf16(v0[0], v0[1]); w.y = cvt_pk_bf16(v0[2], v0[3]); w.z = cvt_pk_bf16(v1[0], v1[1]); w.w = cvt_pk_bf16(v1[2], v1[3]);
                    *(u32x4*)(rowp + bj * HALF) = w; } }
        return false;
    }
};
struct EpiRes {
    static constexpr bool PERM = false;
    const float* srcL; const float* srcC; float* dst; const float* modl; int goff;
    __device__ __forceinline__ bool operator()(f32x4 (&acc)[2][2][4][2], const Unit& u, int wr, int wc, int fr, int fq) const {
        const int row0 = u.pm * BM + wr * 64 + fr, col0 = u.pn * BM + wc * 32 + 4 * fq;
        const int r = (u.pm < 64) ? (u.pm >> 5) : 2;
        const float* gp = modl + r * 12288 + goff + col0;
        f32x4 gv[2][2];
#pragma unroll
        for (int bj = 0; bj < 2; ++bj)
#pragma unroll
            for (int n = 0; n < 2; ++n) gv[bj][n] = *(const f32x4*)(gp + bj * HALF + n * 16);
#pragma unroll
        for (int ai = 0; ai < 2; ++ai)
#pragma unroll
            for (int m = 0; m < 4; ++m) { const int row = row0 + ai * HALF + m * 16;
                const float* sp = ((row < ML) ? srcL + (size_t)row * 2048 : srcC + (size_t)(row - ML) * 2048) + col0; float* dp = dst + (size_t)row * 2048 + col0;
#pragma unroll
                for (int bj = 0; bj < 2; ++bj)
#pragma unroll
                    for (int n = 0; n < 2; ++n) { const f32x4 xo = *(const f32x4*)(sp + bj * HALF + n * 16); *(f32x4*)(dp + bj * HALF + n * 16) = xo + gv[bj][n] * acc[ai][bj][m][n]; }
                asm volatile("" ::: "memory"); }
        return false;
    }
};
struct EpiPart {
    static constexpr bool PERM = false;
    float* part; int ksub;
    __device__ __forceinline__ bool operator()(f32x4 (&acc)[2][2][4][2], const Unit& u, int wr, int wc, int fr, int fq) const {
        const int row0 = u.pm * BM + wr * 64 + fr - ML, col0 = u.pn * BM + wc * 32 + 4 * fq, ks = u.ak / ksub;
#pragma unroll
        for (int ai = 0; ai < 2; ++ai)
#pragma unroll
            for (int m = 0; m < 4; ++m) { float* dp = part + ((size_t)ks * MC + (row0 + ai * HALF + m * 16)) * 2048 + col0;
#pragma unroll
                for (int bj = 0; bj < 2; ++bj)
#pragma unroll
                    for (int n = 0; n < 2; ++n) *(f32x4*)(dp + bj * HALF + n * 16) = acc[ai][bj][m][n]; }
        return false;
    }
};
struct EpiBr {
    static constexpr bool PERM = true;
    const bf16_t* G; bf16_t* O;
    __device__ __forceinline__ bool operator()(f32x4 (&acc)[2][2][4][2], const Unit& u, int wr, int wc, int fr, int fq) const {
        const int row0 = u.pm * BM + wr * 64 + fr, col0 = u.pn * BM + wc * 32 + 8 * fq;
        const bool lastb = (u.br == 3);
#pragma unroll
        for (int ai = 0; ai < 2; ++ai)
#pragma unroll
            for (int m = 0; m < 4; ++m) { const size_t row = (size_t)(row0 + ai * HALF + m * 16);
#pragma unroll
                for (int bj = 0; bj < 2; ++bj) {
                    const u32x4 gc = *(const u32x4*)(G + row * 8192 + u.br * 2048 + col0 + bj * HALF);
                    float fc[8]; unpack8(gc, fc);
                    if (!lastb) {
                        const u32x4 gn = *(const u32x4*)(G + row * 8192 + (u.br + 1) * 2048 + col0 + bj * HALF);
                        float fn[8]; unpack8(gn, fn);
#pragma unroll
                        for (int j = 0; j < 8; ++j) fc[j] = fc[j] * rcp_(fmaxf(fn[j], 1e-30f));
                    }
                    f32x4 v0 = acc[ai][bj][m][0], v1 = acc[ai][bj][m][1];
#pragma unroll
                    for (int j = 0; j < 4; ++j) { v0[j] *= fc[j]; v1[j] *= fc[4 + j]; }
                    acc[ai][bj][m][0] = v0; acc[ai][bj][m][1] = v1;
                    if (lastb) { u32x4 w; w.x = cvt_pk_bf16(v0[0], v0[1]); w.y = cvt_pk_bf16(v0[2], v0[3]); w.z = cvt_pk_bf16(v1[0], v1[1]); w.w = cvt_pk_bf16(v1[2], v1[3]);
                        *(u32x4*)(O + row * 2048 + col0 + bj * HALF) = w; }
                }
                asm volatile("" ::: "memory"); }
        return !lastb;
    }
};
}

__device__ void phase_mod(const Params& p, LAS unsigned char* lds) {
    LAS float* sl = (LAS float*)lds;
    LAS float* red = (LAS float*)(lds + 24576);
    float* MOD = (float*)(p.ws + OFF_MOD);
    const int tid = otid();
    if ((int)blockIdx.x >= 192) return;
    for (int i = tid; i < 3 * 2048; i += 512) { const int r = i >> 11, k = i & 2047; const float v = (r < 2) ? p.c[r * 2048 + k] : p.c_ctx[k]; sl[i] = v * sigm(v); }
    __syncthreads();
    for (int item = blockIdx.x; item < 192; item += gridDim.x) {
        const int l = item / 96, cb = item % 96, cg4 = tid & 31, ksl = tid >> 5;
        const float* W = p.ada_w + ((size_t)l * 2048 + ksl * 128) * 12288 + cb * 128 + cg4 * 4;
        f32x4 a0 = {0.f, 0.f, 0.f, 0.f}, a1 = a0, a2 = a0;
#pragma unroll 8
        for (int k = 0; k < 128; ++k) { const f32x4 w = *(const f32x4*)(W + (size_t)k * 12288);
            a0 += sl[ksl * 128 + k] * w; a1 += sl[2048 + ksl * 128 + k] * w; a2 += sl[4096 + ksl * 128 + k] * w; }
        *(LAS f32x4*)(red + (ksl * 3 + 0) * 128 + cg4 * 4) = a0; *(LAS f32x4*)(red + (ksl * 3 + 1) * 128 + cg4 * 4) = a1; *(LAS f32x4*)(red + (ksl * 3 + 2) * 128 + cg4 * 4) = a2;
        __syncthreads();
        if (tid < 384) { const int r = tid >> 7, cc = tid & 127; float s = 0.f;
#pragma unroll
            for (int ks = 0; ks < 16; ++ks) s += red[(ks * 3 + r) * 128 + cc];
            MOD[(l * 3 + r) * 12288 + cb * 128 + cc] = s + p.ada_b[l * 12288 + cb * 128 + cc]; }
        __syncthreads();
    }
}

__device__ void phase_convert(const Params& p, int l, LAS unsigned char* lds, int t0, int t1, int w, int nw) {
    LAS float* tile = (LAS float*)lds;
    const int tid = otid();
    for (int T = t0 + w; T < t1; T += nw) {
        const float* src; bf16_t* dst; int K, Nsrc, t = T;
        if (t < 3328) { src = p.w_in + (size_t)l * 2048 * INC; K = 2048; Nsrc = INC; dst = (bf16_t*)(p.ws + OFF_WIN); }
        else if ((t -= 3328) < 4096) { const int i = t >> 10; t &= 1023; src = p.gate_w + (size_t)(l * 4 + i) * 2048 * 2048; K = 2048; Nsrc = 2048; dst = (bf16_t*)(p.ws + OFF_WGT) + (size_t)i * 2048 * 2048; }
        else if ((t -= 4096) < 1024) { const int i = t >> 8; t &= 255; src = p.br_w + (size_t)(l * 4 + i) * 512 * 2048; K = 512; Nsrc = 2048; dst = (bf16_t*)(p.ws + OFF_WBR) + (size_t)i * 2048 * 512; }
        else if ((t -= 1024) < 1024) { src = p.out_w + (size_t)l * 2048 * 2048; K = 2048; Nsrc = 2048; dst = (bf16_t*)(p.ws + OFF_WOUT); }
        else if ((t -= 1024) < 4096) { src = p.ffn_w1 + (size_t)l * 2048 * 8192; K = 2048; Nsrc = 8192; dst = (bf16_t*)(p.ws + OFF_W1); }
        else { t -= 4096; src = p.ffn_w2 + (size_t)l * 8192 * 2048; K = 8192; Nsrc = 2048; dst = (bf16_t*)(p.ws + OFF_W2); }
        const int ntk = K >> 6, tk = t % ntk, tn = t / ntk;
#pragma unroll
        for (int i = 0; i < 8; ++i) { const int e = tid + 512 * i, kk = e >> 6, nn = e & 63, n = tn * 64 + nn;
            tile[kk * 65 + nn] = (n < Nsrc) ? src[(size_t)(tk * 64 + kk) * Nsrc + n] : 0.f; }
        __syncthreads();
        { const int nn = tid >> 3, k8 = (tid & 7) * 8; float f[8];
#pragma unroll
          for (int j = 0; j < 8; ++j) f[j] = tile[(k8 + j) * 65 + nn];
          *(u32x4*)(dst + (size_t)(tn * 64 + nn) * K + tk * 64 + k8) = pack8(f); }
        __syncthreads();
    }
}

__device__ void build_wx1(const Params& p, int l) {
    bf16_t* WX = (bf16_t*)(p.ws + OFF_WX1);
    for (int idx = blockIdx.x * 512 + otid(); idx < 2560 * 384; idx += gridDim.x * 512) {
        const int n = idx / 384, k = idx - n * 384; float v = 0.f;
        if (n < 1024) { const int z = n >> 9, c = n & 511, kk = k - z * 64; if (kk >= 0 && kk < 64) v = p.rw_w_up[((size_t)(l * 2 + z) * 64 + kk) * 512 + c]; }
        else if (n < 2048) { const int z = (n - 1024) >> 9, c = n & 511, kk = k - 128 - z * 64; if (kk >= 0 && kk < 64) v = p.rw_a_up[((size_t)(l * 2 + z) * 64 + kk) * 512 + c]; }
        else { const int c = n - 2048, kk = k - 256; if (kk >= 0) v = p.rw_g_up[((size_t)l * 128 + kk) * 512 + c]; }
        WX[idx] = f2bf(v);
    }
}

__device__ void build_wx2(const Params& p, int l) {
    bf16_t* WX = (bf16_t*)(p.ws + OFF_WX2);
    for (int idx = blockIdx.x * 512 + otid(); idx < 2048 * 512; idx += gridDim.x * 512) {
        const int n = idx >> 9, k = idx & 511, gz = n >> 9, z = gz & 1, ch = n & 511, nb = ch >> 6, j = ch & 63, kk = k - nb * 64; float v = 0.f;
        if (kk >= 0 && kk < 64) { const size_t wi = (((size_t)(l * 2 + z) * 8 + nb) * 64 + kk) * 64 + j; v = (gz >> 1) ? p.lru_w_x[wi] : p.lru_w_a[wi]; }
        WX[idx] = f2bf(v);
    }
}
__device__ void build_xc(const Params& p, int l) {
    const bf16_t* U = (const bf16_t*)(p.ws + OFF_U); bf16_t* XC = (bf16_t*)(p.ws + OFF_XC);
    for (int idx = blockIdx.x * 512 + otid(); idx < MT * 64; idx += gridDim.x * 512) {
        const int m = idx >> 6, c8 = (idx & 63) * 8;
        const bool isctx = m >= ML; int b, L, pcur;
        if (!isctx) { b = m >> 13; const int t = m & 8191; pcur = (t & 63) * 128 + (t >> 6); L = SEQ; } else { const int mm = m - ML; b = mm >> 8; pcur = mm & 255; L = CTX; }
        float acc[8];
        { const f32x4 c0 = *(const f32x4*)(p.lru_conv_b + l * 512 + c8), c1 = *(const f32x4*)(p.lru_conv_b + l * 512 + c8 + 4);
          acc[0] = c0.x; acc[1] = c0.y; acc[2] = c0.z; acc[3] = c0.w; acc[4] = c1.x; acc[5] = c1.y; acc[6] = c1.z; acc[7] = c1.w; }
#pragma unroll
        for (int jt = 0; jt < 4; ++jt) { const int pp = pcur + jt - 2;
            if (pp >= 0 && pp < L) { const int row = isctx ? (ML + b * CTX + pp) : (b * SEQ + ((pp & 127) * 64 + (pp >> 7)));
                float x[8]; unpack8(*(const u32x4*)(U + (size_t)row * INP + C_LRU_X + c8), x);
                const f32x4 w0 = *(const f32x4*)(p.lru_conv_w + (l * 4 + jt) * 512 + c8), w1 = *(const f32x4*)(p.lru_conv_w + (l * 4 + jt) * 512 + c8 + 4);
                acc[0] += w0.x * x[0]; acc[1] += w0.y * x[1]; acc[2] += w0.z * x[2]; acc[3] += w0.w * x[3]; acc[4] += w1.x * x[4]; acc[5] += w1.y * x[5]; acc[6] += w1.z * x[6]; acc[7] += w1.w * x[7]; } }
        *(u32x4*)(XC + (size_t)m * 512 + c8) = pack8(acc);
    }
}
__device__ void build_kk_la(const Params& p, int l) {
    const bf16_t* U = (const bf16_t*)(p.ws + OFF_U); bf16_t* NKK = (bf16_t*)(p.ws + OFF_NKK); bf16_t* LA = (bf16_t*)(p.ws + OFF_LA);
    for (int idx = blockIdx.x * 512 + otid(); idx < MT * 64; idx += gridDim.x * 512) {
        const int m = idx >> 6, q = idx & 63, c8 = q * 8;
        { float k[8]; unpack8(*(const u32x4*)(U + (size_t)m * INP + C_RW_K + c8), k);
          const f32x4 w0 = *(const f32x4*)(p.rw_k_k + l * 512 + c8), w1 = *(const f32x4*)(p.rw_k_k + l * 512 + c8 + 4);
          k[0] *= w0.x; k[1] *= w0.y; k[2] *= w0.z; k[3] *= w0.w; k[4] *= w1.x; k[5] *= w1.y; k[6] *= w1.z; k[7] *= w1.w;
          float ss = 0.f;
#pragma unroll
          for (int j = 0; j < 8; ++j) ss += k[j] * k[j];
          ss = red8(ss);
          const float inv = -1.0f / fmaxf(sqrtf(ss), 1e-12f);
#pragma unroll
          for (int j = 0; j < 8; ++j) k[j] *= inv;
          *(u32x4*)(NKK + (size_t)m * 512 + c8) = pack8(k); }
        { const int z = q >> 5, g8 = (q & 31) * 8;
          float wd[16]; { float t0[8], t1[8]; unpack8(*(const u32x4*)(U + (size_t)m * INP + C_GLA_W + z * 16), t0); unpack8(*(const u32x4*)(U + (size_t)m * INP + C_GLA_W + z * 16 + 8), t1);
#pragma unroll
            for (int j = 0; j < 8; ++j) { wd[j] = t0[j]; wd[8 + j] = t1[j]; } }
          float d[8];
          { const f32x4 b0 = *(const f32x4*)(p.gla_w0 + (l * 2 + z) * 256 + g8), b1 = *(const f32x4*)(p.gla_w0 + (l * 2 + z) * 256 + g8 + 4);
            d[0] = b0.x; d[1] = b0.y; d[2] = b0.z; d[3] = b0.w; d[4] = b1.x; d[5] = b1.y; d[6] = b1.z; d[7] = b1.w; }
#pragma unroll
          for (int r = 0; r < 16; ++r) { const float* wp = p.gla_w_up + ((size_t)(l * 2 + z) * 16 + r) * 256 + g8; const f32x4 u0 = *(const f32x4*)wp, u1 = *(const f32x4*)(wp + 4);
              d[0] += wd[r] * u0.x; d[1] += wd[r] * u0.y; d[2] += wd[r] * u0.z; d[3] += wd[r] * u0.w; d[4] += wd[r] * u1.x; d[5] += wd[r] * u1.y; d[6] += wd[r] * u1.z; d[7] += wd[r] * u1.w; }
#pragma unroll
          for (int j = 0; j < 8; ++j) d[j] = log_sigm(d[j]) * (1.0f / 16.0f);
          *(u32x4*)(LA + ((size_t)z * MT + m) * 256 + g8) = pack8(d); }
    }
}
__device__ void build_ax1(const Params& p) {
    const bf16_t* U = (const bf16_t*)(p.ws + OFF_U); bf16_t* AX = (bf16_t*)(p.ws + OFF_AX1);
    for (int idx = blockIdx.x * 512 + otid(); idx < MT * 48; idx += gridDim.x * 512) {
        const int m = idx / 48, q = idx - m * 48;
        float f[8]; unpack8(*(const u32x4*)(U + (size_t)m * INP + C_RW_W + q * 8), f);
        if (q < 16) {
#pragma unroll
            for (int j = 0; j < 8; ++j) f[j] = tanh_(f[j]); }
        else if (q >= 32) {
#pragma unroll
            for (int j = 0; j < 8; ++j) f[j] = sigm(f[j]); }
        *(u32x4*)(AX + (size_t)m * 384 + q * 8) = pack8(f);
    }
}

__device__ void phase_norm(const float* srcL, const float* srcC, const float* nw, const float* modl, int shoff, int scoff, bf16_t* dst, int M,
                           const float* part = nullptr, int nsplit = 0, const float* pgate = nullptr, float* wb = nullptr) {
    const int tid = otid(), wid = tid >> 6, lane = tid & 63;
    for (int m = blockIdx.x * 8 + wid; m < M; m += gridDim.x * 8) {
        const float* xr = (m < ML) ? srcL + (size_t)m * 2048 : srcC + (size_t)(m - ML) * 2048;
        const float* mr = modl + ((m < ML) ? (m >> 13) : 2) * 12288;
        f32x4 v[8]; float ss = 0.f;
#pragma unroll
        for (int j = 0; j < 8; ++j) v[j] = *(const f32x4*)(xr + j * 256 + lane * 4);
        if (nsplit > 0 && m >= ML) {
#pragma unroll
            for (int j = 0; j < 8; ++j) { const int col = j * 256 + lane * 4; f32x4 a = {0.f, 0.f, 0.f, 0.f};
                for (int sidx = 0; sidx < nsplit; ++sidx) a += *(const f32x4*)(part + ((size_t)sidx * MC + (m - ML)) * 2048 + col);
                v[j] += *(const f32x4*)(pgate + col) * a;
                if (wb) *(f32x4*)(wb + (size_t)m * 2048 + col) = v[j]; }
        }
#pragma unroll
        for (int j = 0; j < 8; ++j) ss += v[j].x * v[j].x + v[j].y * v[j].y + v[j].z * v[j].z + v[j].w * v[j].w;
        ss = wave_sum(ss);
        const float rs = rsqrtf(ss * (1.0f / 2048.0f) + EPS);
#pragma unroll
        for (int j = 0; j < 8; ++j) { const int col = j * 256 + lane * 4;
            const f32x4 w = *(const f32x4*)(nw + col), sh = *(const f32x4*)(mr + shoff + col), sc = *(const f32x4*)(mr + scoff + col);
            const f32x4 y = (v[j] * rs * w) * (1.0f + sc) + sh;
            u32x2 o; o.x = cvt_pk_bf16(y.x, y.y); o.y = cvt_pk_bf16(y.z, y.w);
            *(u32x2*)(dst + (size_t)m * 2048 + col) = o; }
    }
}
__device__ void phase_final_norm(const float* src, const float* nw, float* out) {
    const int tid = otid(), wid = tid >> 6, lane = tid & 63;
    for (int m = blockIdx.x * 8 + wid; m < ML; m += gridDim.x * 8) {
        const float* xr = src + (size_t)m * 2048;
        f32x4 v[8]; float ss = 0.f;
#pragma unroll
        for (int j = 0; j < 8; ++j) { v[j] = *(const f32x4*)(xr + j * 256 + lane * 4); ss += v[j].x * v[j].x + v[j].y * v[j].y + v[j].z * v[j].z + v[j].w * v[j].w; }
        ss = wave_sum(ss);
        const float rs = rsqrtf(ss * (1.0f / 2048.0f) + EPS);
#pragma unroll
        for (int j = 0; j < 8; ++j) { const int col = j * 256 + lane * 4; const f32x4 w = *(const f32x4*)(nw + col);
            *(f32x4*)(out + (size_t)m * 2048 + col) = v[j] * rs * w; }
    }
}

constexpr int TOKT = 66;
__device__ __forceinline__ void phase_prep(const Params& p, int l, LAS unsigned char* lds, int parts) {
    const int tid = otid(), lane = tid & 63;
    const bf16_t* U = (const bf16_t*)(p.ws + OFF_U);
    bf16_t* LW = (bf16_t*)(p.ws + OFF_LW); bf16_t* AA = (bf16_t*)(p.ws + OFF_AA); bf16_t* NKK = (bf16_t*)(p.ws + OFF_NKK); bf16_t* LA = (bf16_t*)(p.ws + OFF_LA);
    if (parts & 1) {
        LAS float* tw = (LAS float*)lds;
        LAS float* ad = (LAS float*)(lds + TOKT * 128 * 4);
        LAS float* gw = (LAS float*)(lds + 2 * TOKT * 128 * 4);
        for (int tile = blockIdx.x; tile < MT / TOKT; tile += gridDim.x) {
            const int m0 = tile * TOKT;
            { const int tid = otid();
            for (int e = tid; e < TOKT * 32; e += 512) { const int tok = e >> 5, jj = e & 31; gw[e] = bf2f(U[(size_t)(m0 + tok) * INP + C_GLA_W + jj]); } }
            __syncthreads();
            { const int c = otid(); const float kkw = p.rw_k_k[l * 512 + c];
              _Pragma("unroll 1") for (int tok = 0; tok < TOKT; ++tok) { const float val = bf2f(U[(size_t)(m0 + tok) * INP + C_RW_K + c]) * kkw;
                  const float ss = wave_sum(val * val); NKK[(size_t)(m0 + tok) * 512 + c] = f2bf(-val / fmaxf(sqrtf(ss), 1e-12f)); } }
            { const int tid = otid(); const int z = tid >> 8, cc = tid & 255; float gcol[16];
              const float* gwb = p.gla_w_up + (size_t)l * 2 * 16 * 256; asm volatile("" : "+s"(gwb));
#pragma unroll
              for (int j = 0; j < 16; ++j) gcol[j] = gwb[(unsigned)((z * 16 + j) * 256 + cc)];
              const float w0 = p.gla_w0[(l * 2 + z) * 256 + cc];
              _Pragma("unroll 1") for (int tok = 0; tok < TOKT; ++tok) { float d = w0;
#pragma unroll
                  for (int j = 0; j < 16; ++j) d += gw[tok * 32 + z * 16 + j] * gcol[j];
                  LA[((size_t)z * MT + m0 + tok) * 256 + cc] = f2bf(log_sigm(d) * (1.0f / 16.0f)); } }
            __syncthreads();
        }
    }
    if (parts & 2) {
        const bf16_t* GATES = (const bf16_t*)(p.ws + OFF_GATES); const bf16_t* XC = (const bf16_t*)(p.ws + OFF_XC);
        bf16_t* LACUM = (bf16_t*)(p.ws + OFF_LACUM); bf16_t* LHLOC = (bf16_t*)(p.ws + OFF_LHLOC);
        float* APROD = (float*)(p.ws + OFF_APROD); float* HEND = (float*)(p.ws + OFF_HEND);
        for (int item = blockIdx.x; item < 2 * 2 * NCH; item += gridDim.x) {
            const int ch = otid();
            const int z = item / (2 * NCH), b = (item / NCH) & 1, cidx = item % NCH;
            const bool isctx = cidx < 8; const int p0 = (isctx ? cidx : cidx - 8) * 32;
            auto rowof = [&](int pp) -> int { return isctx ? (ML + b * CTX + pp) : (b * SEQ + ((pp & 127) * 64 + (pp >> 7))); };
            const float sp = softplus_(-p.lru_lambda[(l * 2 + z) * 512 + ch]);
            float h = 0.f, Ac = 1.f;
#pragma unroll 1
            for (int half = 0; half < 2; ++half) {
                bf16_t rgv[16], igv[16], xcv[16]; int rows[16];
#pragma unroll
                for (int i = 0; i < 16; ++i) { const int ii = half * 16 + i, pp = z ? 31 - ii : ii; const int m = rowof(p0 + pp); rows[i] = m;
                    rgv[i] = GATES[((size_t)z * MT + m) * 512 + ch]; igv[i] = GATES[((size_t)(2 + z) * MT + m) * 512 + ch]; xcv[i] = XC[(size_t)m * 512 + ch]; }
#pragma unroll
                for (int i = 0; i < 16; ++i) { const float log_a = -8.0f * bf2f(rgv[i]) * sp, a = __expf(log_a);
                    const float bt = sqrtf(-expm1f(2.0f * log_a)) * bf2f(igv[i]) * bf2f(xcv[i]);
                    h = a * h + bt; Ac *= a;
                    const size_t o = ((size_t)z * MT + rows[i]) * 512 + ch;
                    LACUM[o] = f2bf(Ac); LHLOC[o] = f2bf(h); }
            }
            const size_t so = ((size_t)(z * 2 + b) * NCH + cidx) * 512 + ch;
            APROD[so] = Ac; HEND[so] = h;
        }
    }
}

template <int MIX> struct ScanCfg;
template <> struct ScanCfg<0> { static constexpr int STEPF = 352, EPL = 8, NRAW = 22; };
template <> struct ScanCfg<1> { static constexpr int STEPF = 224, EPL = 8, NRAW = 14; };
template <> struct ScanCfg<2> { static constexpr int STEPF = 292, EPL = 16, NRAW = 19; };
template <> struct ScanCfg<3> { static constexpr int STEPF = 292, EPL = 16, NRAW = 19; };

template <int MIX>
__device__ void scan_role(const Params& p, const int l, LAS unsigned char* lds, const int chain, const int sub) {
    constexpr int STEPF = ScanCfg<(MIX)>::STEPF, EPL = ScanCfg<(MIX)>::EPL, NRAW = ScanCfg<(MIX)>::NRAW, BUFB = 45056;
    const int tid = otid(), wid = tid >> 6, lane = tid & 63, rs = lane >> 4, ks = lane & 15, row = wid * 4 + rs;
    const bf16_t* U = (const bf16_t*)(p.ws + OFF_U);
    const bf16_t* LW = (const bf16_t*)(p.ws + OFF_LW); const bf16_t* AA = (const bf16_t*)(p.ws + OFF_AA); const bf16_t* NKK = (const bf16_t*)(p.ws + OFF_NKK); const bf16_t* LA = (const bf16_t*)(p.ws + OFF_LA);
    int z, b, h;
    if (MIX == 0) { z = chain >> 4; b = (chain >> 3) & 1; h = chain & 7; } else { z = chain >> 3; b = (chain >> 2) & 1; h = chain & 3; }
    LAS float* ylds = (LAS float*)(lds + 2 * BUFB);
    auto tokrow = [&](int sg) -> int { if (sg < CTX) { const int t = z ? (CTX - 1 - sg) : sg; return ML + b * CTX + t; } const int s2 = sg - CTX; const int t = z ? (SEQ - 1 - s2) : s2; return b * SEQ + t; };
    float fb = 0.f, ib = 0.f;
    if (MIX >= 2) { fb = p.ml_f_b[(l * 2 + z) * 4 + h]; ib = p.ml_i_b[(l * 2 + z) * 4 + h]; }
    const int stid = tid & 255, sq = stid & 15;
    f32x4 ka4 = {0.f, 0.f, 0.f, 0.f};
    if (MIX == 0) ka4 = *(const f32x4*)(p.rw_k_a + l * 512 + h * 64 + sq * 4);
    struct Raw { u32x4 q0, q1; u32x2 d0, d1, d2, d3, d4; unsigned v; };
    Raw rwA, rwB; bf16_t rsc = 0;
    rwA.q0 = (u32x4){0u, 0u, 0u, 0u}; rwA.q1 = rwA.q0; rwA.d0 = (u32x2){0u, 0u}; rwA.d1 = rwA.d0; rwA.d2 = rwA.d0; rwA.d3 = rwA.d0; rwA.d4 = rwA.d0; rwA.v = 0u; rwB = rwA;
    auto load_raw1 = [&](int blk, int i, Raw& r) {
        const int sst = (stid >> 4) + 16 * i;
        const size_t m = (size_t)tokrow(blk * 32 + sst);
        if (MIX == 0) { const int cc = h * 64 + sq * 4;
            r.d0 = *(const u32x2*)(LW + ((size_t)z * MT + m) * 512 + cc); r.d1 = *(const u32x2*)(NKK + m * 512 + cc); r.d2 = *(const u32x2*)(AA + ((size_t)z * MT + m) * 512 + cc);
            r.d3 = *(const u32x2*)(U + m * INP + C_RW_K + cc); r.d4 = *(const u32x2*)(U + m * INP + C_RW_R + cc);
            r.v = *(const unsigned*)(U + m * INP + C_RW_V + h * 64 + sub * 32 + sq * 2);
        } else if (MIX == 1) { const int cc = h * 64 + sq * 4;
            r.d0 = *(const u32x2*)(LA + ((size_t)z * MT + m) * 256 + cc); r.d1 = *(const u32x2*)(U + m * INP + C_GLA_K + cc); r.d2 = *(const u32x2*)(U + m * INP + C_GLA_Q + cc);
            r.v = *(const unsigned*)(U + m * INP + C_GLA_V + h * 128 + sub * 32 + sq * 2);
        } else { const int cc = h * 128 + sq * 8;
            r.q0 = *(const u32x4*)(U + m * INP + C_ML_K + cc); r.q1 = *(const u32x4*)(U + m * INP + C_ML_Q + cc);
            r.v = *(const unsigned*)(U + m * INP + C_ML_V + h * 128 + sub * 32 + sq * 2);
        }
    };
    auto load_raw = [&](int blk) {
        load_raw1(blk, 0, rwA); load_raw1(blk, 1, rwB);
        if (MIX >= 2 && stid < 64) { const int st = stid & 31, which = (stid >> 5) & 1; const size_t m2 = (size_t)tokrow(blk * 32 + st); rsc = U[m2 * INP + (which ? C_ML_I : C_ML_F) + z * 4 + h]; }
    };
    auto store_img1 = [&](int bufsel, int i, const Raw& r) {
        const int sst = (stid >> 4) + 16 * i;
        LAS float* sp = (LAS float*)(lds + bufsel * BUFB) + sst * STEPF;
        const f32x2 vv = {__uint_as_float(r.v << 16), __uint_as_float(r.v & 0xffff0000u)};
        if (MIX == 0) {
            float lw[4], nk[4], a[4], k[4], rr[4]; unpack4(r.d0, lw); unpack4(r.d1, nk); unpack4(r.d2, a); unpack4(r.d3, k); unpack4(r.d4, rr);
            *(LAS f32x4*)(sp + sq * 4) = (f32x4){__expf(lw[0]), __expf(lw[1]), __expf(lw[2]), __expf(lw[3])};
            *(LAS f32x4*)(sp + 64 + sq * 4) = (f32x4){nk[0], nk[1], nk[2], nk[3]};
            *(LAS f32x4*)(sp + 128 + sq * 4) = (f32x4){-nk[0] * a[0], -nk[1] * a[1], -nk[2] * a[2], -nk[3] * a[3]};
            *(LAS f32x4*)(sp + 192 + sq * 4) = (f32x4){k[0] * (1.0f + (a[0] - 1.0f) * ka4.x), k[1] * (1.0f + (a[1] - 1.0f) * ka4.y), k[2] * (1.0f + (a[2] - 1.0f) * ka4.z), k[3] * (1.0f + (a[3] - 1.0f) * ka4.w)};
            *(LAS f32x4*)(sp + 256 + sq * 4) = (f32x4){rr[0], rr[1], rr[2], rr[3]};
            *(LAS f32x2*)(sp + 320 + sq * 2) = vv;
        } else if (MIX == 1) {
            float la[4], k[4], q[4]; unpack4(r.d0, la); unpack4(r.d1, k); unpack4(r.d2, q);
            *(LAS f32x4*)(sp + sq * 4) = (f32x4){__expf(la[0]), __expf(la[1]), __expf(la[2]), __expf(la[3])};
            *(LAS f32x4*)(sp + 64 + sq * 4) = (f32x4){k[0], k[1], k[2], k[3]};
            *(LAS f32x4*)(sp + 128 + sq * 4) = (f32x4){q[0] * 0.125f, q[1] * 0.125f, q[2] * 0.125f, q[3] * 0.125f};
            *(LAS f32x2*)(sp + 192 + sq * 2) = vv;
        } else {
            float k[8], q[8]; unpack8(r.q0, k); unpack8(r.q1, q);
            const float ksc = 0.08838834764831845f;
            *(LAS f32x4*)(sp + sq * 8) = (f32x4){k[0] * ksc, k[1] * ksc, k[2] * ksc, k[3] * ksc}; *(LAS f32x4*)(sp + sq * 8 + 4) = (f32x4){k[4] * ksc, k[5] * ksc, k[6] * ksc, k[7] * ksc};
            *(LAS f32x4*)(sp + 128 + sq * 8) = (f32x4){q[0], q[1], q[2], q[3]}; *(LAS f32x4*)(sp + 128 + sq * 8 + 4) = (f32x4){q[4], q[5], q[6], q[7]};
            *(LAS f32x2*)(sp + 256 + sq * 2) = (MIX == 3) ? (f32x2){1.0f, 1.0f} : vv;
        }
    };
    auto store_img = [&](int bufsel) {
        store_img1(bufsel, 0, rwA); store_img1(bufsel, 1, rwB);
        if (MIX >= 2 && stid < 64) { const int st = stid & 31, which = stid >> 5; const float xv = bf2f(rsc); LAS float* img = (LAS float*)(lds + bufsel * BUFB);
            if (which == 0) img[st * STEPF + 288] = sigm(xv + fb); else img[st * STEPF + 289] = __expf(xv + ib); }
    };
    f32x2 S2[EPL / 2];
#pragma unroll
    for (int j = 0; j < EPL / 2; ++j) S2[j] = (f32x2){0.f, 0.f};
    bf16_t* Yout = (bf16_t*)(p.ws + (MIX == 0 ? OFF_YRW : (MIX == 1 ? OFF_YGL : OFF_YML)));
    const int cbase = (MIX == 0) ? (h * 64 + sub * 32) : (h * 128 + sub * 32);
    constexpr int NV = EPL / 4;
    const int crs = lane >> 3, cks = lane & 7, crow = wid * 8 + crs;
    struct In { f32x4 a[NV], b[NV], c[NV], d[NV], e[NV]; float v, f, iw; };
    auto load_in = [&](const LAS float* sp) -> In {
        In r;
#pragma unroll
        for (int j = 0; j < NV; ++j) { const int o = (j * 8 + cks) * 4;
            if (MIX == 0) { r.a[j] = *(const LAS f32x4*)(sp + o); r.b[j] = *(const LAS f32x4*)(sp + 64 + o); r.c[j] = *(const LAS f32x4*)(sp + 128 + o); r.d[j] = *(const LAS f32x4*)(sp + 192 + o); r.e[j] = *(const LAS f32x4*)(sp + 256 + o); }
            else if (MIX == 1) { r.a[j] = *(const LAS f32x4*)(sp + o); r.b[j] = *(const LAS f32x4*)(sp + 64 + o); r.c[j] = *(const LAS f32x4*)(sp + 128 + o); r.d[j] = r.a[j]; r.e[j] = r.a[j]; }
            else { r.a[j] = *(const LAS f32x4*)(sp + o); r.c[j] = *(const LAS f32x4*)(sp + 128 + o); r.b[j] = r.a[j]; r.d[j] = r.a[j]; r.e[j] = r.a[j]; } }
        if (MIX == 0) { r.v = sp[320 + crow]; r.f = 0.f; r.iw = 0.f; }
        else if (MIX == 1) { r.v = sp[192 + crow]; r.f = 0.f; r.iw = 0.f; }
        else { r.v = sp[256 + crow]; const f32x2 fi = *(const LAS f32x2*)(sp + 288); r.f = fi.x; r.iw = fi.y; }
        return r;
    };
#define LO2(V_) ((f32x2){(V_)[0], (V_)[1]})
#define HI2(V_) ((f32x2){(V_)[2], (V_)[3]})

    float* DENp = (float*)(p.ws + OFF_DEN);
    auto write_out = [&](int blk) {
        const LAS float* yl = ylds + (blk & 1) * 1024;
        if (MIX < 3) {
#pragma unroll
            for (int i = 0; i < 2; ++i) { const int st = (stid >> 4) + 16 * i, rp = stid & 15; const size_t m = (size_t)tokrow(blk * 32 + st);
                *(unsigned*)(Yout + ((size_t)z * MT + m) * 512 + cbase + 2 * rp) = cvt_pk_bf16(yl[st * 32 + 2 * rp], yl[st * 32 + 2 * rp + 1]); }
        } else if (stid < 32) { const size_t m = (size_t)tokrow(blk * 32 + stid); DENp[((size_t)z * MT + m) * 4 + h] = yl[stid * 32]; }
    };
    if (wid >= 4) { load_raw(0); store_img(0); load_raw(1); }
    __syncthreads();
    for (int blk = 0; blk < NCH; ++blk) {
        if (wid >= 4) {
            if (blk + 1 < NCH) store_img((blk + 1) & 1);
            if (blk >= 1) write_out(blk - 1);
            if (blk + 2 < NCH) load_raw(blk + 2);
        } else {
        LAS float* ylw = ylds + (blk & 1) * 1024;
        const LAS float* img = (const LAS float*)(lds + (blk & 1) * BUFB);
        In cur = load_in(img);
#pragma unroll 1
        for (int g = 0; g < 4; ++g) {
        float pd[8];
#pragma unroll
        for (int s8 = 0; s8 < 8; ++s8) {
            const int st = g * 8 + s8;
            const In nxt = load_in(img + ((st + 1 < 32) ? (st + 1) : 31) * STEPF);
            if (MIX == 0) {
                f32x2 da = S2[0] * LO2(cur.b[0]), db = S2[1] * HI2(cur.b[0]);
                f32x2 t[EPL / 2];
#pragma unroll
                for (int j = 1; j < NV; ++j) { da += S2[2 * j] * LO2(cur.b[j]); db += S2[2 * j + 1] * HI2(cur.b[j]); }
                const f32x2 d0 = da + db;
                float sa = d0.x + d0.y;
#pragma unroll
                for (int j = 0; j < NV; ++j) { t[2 * j] = S2[2 * j] * LO2(cur.a[j]) + LO2(cur.d[j]) * cur.v; t[2 * j + 1] = S2[2 * j + 1] * HI2(cur.a[j]) + HI2(cur.d[j]) * cur.v; }
                sa = red8(sa);
#pragma unroll
                for (int j = 0; j < NV; ++j) { S2[2 * j] = t[2 * j] + LO2(cur.c[j]) * sa; S2[2 * j + 1] = t[2 * j + 1] + HI2(cur.c[j]) * sa; }
                f32x2 ea = S2[0] * LO2(cur.e[0]), eb = S2[1] * HI2(cur.e[0]);
#pragma unroll
                for (int j = 1; j < NV; ++j) { ea += S2[2 * j] * LO2(cur.e[j]); eb += S2[2 * j + 1] * HI2(cur.e[j]); }
                const f32x2 d1 = ea + eb;
                pd[s8] = d1.x + d1.y;
            } else if (MIX == 1) {
#pragma unroll
                for (int j = 0; j < NV; ++j) { S2[2 * j] = S2[2 * j] * LO2(cur.a[j]) + LO2(cur.b[j]) * cur.v; S2[2 * j + 1] = S2[2 * j + 1] * HI2(cur.a[j]) + HI2(cur.b[j]) * cur.v; }
                f32x2 ea = S2[0] * LO2(cur.c[0]), eb = S2[1] * HI2(cur.c[0]);
#pragma unroll
                for (int j = 1; j < NV; ++j) { ea += S2[2 * j] * LO2(cur.c[j]); eb += S2[2 * j + 1] * HI2(cur.c[j]); }
                const f32x2 d1 = ea + eb;
                pd[s8] = d1.x + d1.y;
            } else {
                const float iv = cur.iw * cur.v, f = cur.f;
#pragma unroll
                for (int j = 0; j < NV; ++j) { S2[2 * j] = S2[2 * j] * f + LO2(cur.a[j]) * iv; S2[2 * j + 1] = S2[2 * j + 1] * f + HI2(cur.a[j]) * iv; }
                f32x2 ea = S2[0] * LO2(cur.c[0]), eb = S2[1] * HI2(cur.c[0]);
#pragma unroll
                for (int j = 1; j < NV; ++j) { ea += S2[2 * j] * LO2(cur.c[j]); eb += S2[2 * j + 1] * HI2(cur.c[j]); }
                const f32x2 d1 = ea + eb;
                pd[s8] = d1.x + d1.y;
            }
            cur = nxt;
        }
#pragma unroll
        for (int s8 = 0; s8 < 8; ++s8) pd[s8] += dppmov<0xB1>(pd[s8]);
#pragma unroll
        for (int s8 = 0; s8 < 8; ++s8) pd[s8] += dppmov<0x4E>(pd[s8]);
#pragma unroll
        for (int s8 = 0; s8 < 8; ++s8) pd[s8] += dppmov<0x141>(pd[s8]);
        float yk = pd[0];
#pragma unroll
        for (int s8 = 1; s8 < 8; ++s8) yk = (cks == s8) ? pd[s8] : yk;
        ylw[(g * 8 + cks) * 32 + crow] = yk;
        }
        }
        __syncthreads();
    }
    if (wid >= 4) write_out(NCH - 1);
}

__device__ void lru_carry_role(const Params& p, int zb) {
    const float* APROD = (const float*)(p.ws + OFF_APROD); const float* HEND = (const float*)(p.ws + OFF_HEND); float* CARRY = (float*)(p.ws + OFF_CARRY);
    const int z = zb >> 1, ch = otid(); const size_t base = (size_t)zb * NCH * 512 + ch;
    float h = 0.f;
    for (int g8 = 0; g8 < NCH / 8; ++g8) {
        float a[8], e[8]; int ci[8];
#pragma unroll
        for (int j = 0; j < 8; ++j) { const int i = g8 * 8 + j; ci[j] = (i < 8) ? (z ? 7 - i : i) : (z ? (NCH - 1) - (i - 8) : i); a[j] = APROD[base + (size_t)ci[j] * 512]; e[j] = HEND[base + (size_t)ci[j] * 512]; }
#pragma unroll
        for (int j = 0; j < 8; ++j) { CARRY[base + (size_t)ci[j] * 512] = h; h = a[j] * h + e[j]; }
    }
}

__device__ void phase_scan(const Params& p, int l, LAS unsigned char* lds, int cmask = 31) {
    if (cmask == 31) {
        const int nidle = (int)gridDim.x - 212;
        const int w = nidle > 0 ? (int)blockIdx.x - 212 : (int)blockIdx.x, nw = nidle > 0 ? nidle : (int)gridDim.x;
        if (w >= 0) { phase_convert(p, l, lds, 3328, 17664, w, nw); if (l == 0) phase_convert(p, 1, lds, 0, 3328, w, nw); __syncthreads(); }
    }
    for (int role = blockIdx.x; role < 212; role += gridDim.x) {
        const int cls = role < 64 ? 1 : (role < 128 ? 2 : (role < 192 ? 4 : (role < 208 ? 8 : 16)));
        if (!(cmask & cls)) continue;
        if (role < 64) scan_role<0>(p, l, lds, role >> 1, role & 1);
        else if (role < 128) scan_role<1>(p, l, lds, (role - 64) >> 2, (role - 64) & 3);
        else if (role < 192) scan_role<2>(p, l, lds, (role - 128) >> 2, (role - 128) & 3);
        else if (role < 208) scan_role<3>(p, l, lds, role - 192, 0);
        else lru_carry_role(p, role - 208);
        __syncthreads();
    }
}

__device__ void phase_post(const Params& p, int l, LAS unsigned char* lds) {
    const int tid = otid(), wid = tid >> 6, lane = tid & 63;
    const bf16_t* U = (const bf16_t*)(p.ws + OFF_U);
    const bf16_t* YRW = (const bf16_t*)(p.ws + OFF_YRW); const bf16_t* YGL = (const bf16_t*)(p.ws + OFF_YGL); const bf16_t* YML = (const bf16_t*)(p.ws + OFF_YML);
    const float* DEN = (const float*)(p.ws + OFF_DEN);
    const bf16_t* LACUM = (const bf16_t*)(p.ws + OFF_LACUM); const bf16_t* LHLOC = (const bf16_t*)(p.ws + OFF_LHLOC); const float* CARRY = (const float*)(p.ws + OFF_CARRY);
    bf16_t* YS = (bf16_t*)(p.ws + OFF_YS); const bf16_t* GV = (const bf16_t*)(p.ws + OFF_GV);
    {
        const int c8 = lane * 8;
        float lnw8[8], rk8[8];
        { const f32x4 a0 = *(const f32x4*)(p.rw_ln_w + l * 512 + c8), a1 = *(const f32x4*)(p.rw_ln_w + l * 512 + c8 + 4), b0 = *(const f32x4*)(p.rw_r_k + l * 512 + c8), b1 = *(const f32x4*)(p.rw_r_k + l * 512 + c8 + 4);
          lnw8[0] = a0.x; lnw8[1] = a0.y; lnw8[2] = a0.z; lnw8[3] = a0.w; lnw8[4] = a1.x; lnw8[5] = a1.y; lnw8[6] = a1.z; lnw8[7] = a1.w;
          rk8[0] = b0.x; rk8[1] = b0.y; rk8[2] = b0.z; rk8[3] = b0.w; rk8[4] = b1.x; rk8[5] = b1.y; rk8[6] = b1.z; rk8[7] = b1.w; }
        _Pragma("unroll 1") for (int mi = blockIdx.x * 8 + wid; mi < MT; mi += gridDim.x * 8) { const size_t m = (size_t)mi;
            { float y0[8], y1[8], r[8], k[8], v[8], g[8], oo[8];
              unpack8(*(const u32x4*)(YRW + m * 512 + c8), y0); unpack8(*(const u32x4*)(YRW + ((size_t)MT + m) * 512 + c8), y1);
              unpack8(*(const u32x4*)(U + m * INP + C_RW_R + c8), r); unpack8(*(const u32x4*)(U + m * INP + C_RW_K + c8), k); unpack8(*(const u32x4*)(U + m * INP + C_RW_V + c8), v);
              unpack8(*(const u32x4*)(GV + m * 512 + c8), g);
              float ss = 0.f, bs = 0.f;
#pragma unroll
              for (int j = 0; j < 8; ++j) { y0[j] += y1[j]; ss += y0[j] * y0[j]; bs += r[j] * k[j] * rk8[j]; }
              ss = red8(ss); bs = red8(bs);
              const float rn = rsqrtf(ss * (1.0f / 64.0f) + EPS);
#pragma unroll
              for (int j = 0; j < 8; ++j) oo[j] = (y0[j] * rn * lnw8[j] + bs * v[j]) * g[j];
              *(u32x4*)(YS + m * 2048 + c8) = pack8(oo); }
            int b, cidx;
            if (m < (size_t)ML) { b = (int)(m >> 13); const int t = (int)(m & 8191); const int pp = (t & 63) * 128 + (t >> 6); cidx = 8 + (pp >> 5); }
            else { const int mm = (int)m - ML; b = mm >> 8; cidx = (mm & 255) >> 5; }
            float o[8];
            { float hs[8];
#pragma unroll
              for (int j = 0; j < 8; ++j) hs[j] = 0.f;
#pragma unroll
              for (int z = 0; z < 2; ++z) { float ac[8], hl[8]; unpack8(*(const u32x4*)(LACUM + ((size_t)z * MT + m) * 512 + c8), ac); unpack8(*(const u32x4*)(LHLOC + ((size_t)z * MT + m) * 512 + c8), hl);
                  const float* cp = CARRY + ((size_t)(z * 2 + b) * NCH + cidx) * 512 + c8; const f32x4 c0 = *(const f32x4*)cp, c1 = *(const f32x4*)(cp + 4);
                  hs[0] += ac[0] * c0.x + hl[0]; hs[1] += ac[1] * c0.y + hl[1]; hs[2] += ac[2] * c0.z + hl[2]; hs[3] += ac[3] * c0.w + hl[3];
                  hs[4] += ac[4] * c1.x + hl[4]; hs[5] += ac[5] * c1.y + hl[5]; hs[6] += ac[6] * c1.z + hl[6]; hs[7] += ac[7] * c1.w + hl[7]; }
              float gb[8]; unpack8(*(const u32x4*)(U + m * INP + C_LRU_G + c8), gb);
#pragma unroll
              for (int j = 0; j < 8; ++j) o[j] = hs[j] * gelu_tanh(gb[j]);
              *(u32x4*)(YS + m * 2048 + 512 + c8) = pack8(o); }
            { float a0[8], a1[8]; unpack8(*(const u32x4*)(YGL + m * 512 + c8), a0); unpack8(*(const u32x4*)(YGL + ((size_t)MT + m) * 512 + c8), a1);
              float ss = 0.f;
#pragma unroll
              for (int j = 0; j < 8; ++j) { a0[j] += a1[j]; ss += a0[j] * a0[j]; }
              ss = red16(ss);
              const float rn = rsqrtf(ss * (1.0f / 128.0f) + EPS);
              float rg[8]; unpack8(*(const u32x4*)(U + m * INP + C_GLA_R + c8), rg);
              const float* lw = p.gla_ln_w + l * 512 + c8;
#pragma unroll
              for (int j = 0; j < 8; ++j) o[j] = a0[j] * rn * lw[j] * (rg[j] * sigm(rg[j]));
              *(u32x4*)(YS + m * 2048 + 1024 + c8) = pack8(o); }
            { float a0[8], a1[8]; unpack8(*(const u32x4*)(YML + m * 512 + c8), a0); unpack8(*(const u32x4*)(YML + ((size_t)MT + m) * 512 + c8), a1);
              const int hd = lane >> 4; const float d0 = DEN[m * 4 + hd], d1 = DEN[((size_t)MT + m) * 4 + hd];
              const float i0 = 1.0f / fmaxf(fabsf(d0), 1.0f), i1 = 1.0f / fmaxf(fabsf(d1), 1.0f);
              float ss = 0.f;
#pragma unroll
              for (int j = 0; j < 8; ++j) { a0[j] = a0[j] * i0 + a1[j] * i1; ss += a0[j] * a0[j]; }
              ss = red16(ss);
              const float rn = rsqrtf(ss * (1.0f / 128.0f) + EPS);
              float og[8]; unpack8(*(const u32x4*)(U + m * INP + C_ML_O + c8), og);
              const float* lw = p.ml_ln_w + l * 512 + c8;
#pragma unroll
              for (int j = 0; j < 8; ++j) o[j] = a0[j] * rn * lw[j] * sigm(og[j]);
              *(u32x4*)(YS + m * 2048 + 1536 + c8) = pack8(o); }
        }
    }
}


#define XB_TMO      128
#define XB_XCNT(j)  (256  + 64 * (j))
#define XB_XSUB(j)  (1280 + 64 * (j))
#define XB_XGEN(j)  (2304 + 64 * (j))
#define XB_TOP      3328
#define XB_TOPGEN   3392
#define XCD_BAR_WORDS 3456
#define XB_SPIN_CAP (1u << 22)
__device__ __forceinline__ unsigned xb_ld(unsigned* p)              { return __hip_atomic_load(p, __ATOMIC_RELAXED, __HIP_MEMORY_SCOPE_AGENT); }
__device__ __forceinline__ unsigned xb_add(unsigned* p, unsigned v) { return __hip_atomic_fetch_add(p, v, __ATOMIC_RELAXED, __HIP_MEMORY_SCOPE_AGENT); }
__device__ __forceinline__ unsigned xb_xcc_id() { return (unsigned)__builtin_amdgcn_s_getreg((3 << 11) | 20) & 0xFu; }
#define XB_SPIN(cond, bar) do { unsigned _sp = 0; while (cond) { __builtin_amdgcn_s_sleep(1); \
    if ((++_sp & 255u) == 0u) { if (xb_ld(&(bar)[XB_TMO])) break; if (_sp > XB_SPIN_CAP) { atomicAdd(&(bar)[XB_TMO], 1u); break; } } } } while (0)
struct XcdBarrier { unsigned* bar; unsigned x; volatile LAS unsigned* st; };
__device__ __forceinline__ XcdBarrier xcd_barrier_post(unsigned* bar, volatile LAS unsigned* st) {
    XcdBarrier b; b.bar = bar; b.x = xb_xcc_id(); b.st = st;
    if (threadIdx.x == 0) (void)xb_add(&bar[XB_XCNT(b.x)], 1u);
    return b;
}
__device__ __forceinline__ void xcd_barrier_complete(unsigned* bar, unsigned x, unsigned& nloc, unsigned& nx) {
    const unsigned G = gridDim.x * gridDim.y * gridDim.z;
    unsigned sum, cnt, mine, sp = 0u;
    for (;;) {
        sum = 0u; cnt = 0u; mine = 0u;
#pragma unroll
        for (unsigned j = 0; j < 16; ++j) { const unsigned c = xb_ld(&bar[XB_XCNT(j)]); sum += c; cnt += (c > 0u) ? 1u : 0u; mine = (j == x) ? c : mine; }
        if (sum == G) break;
        __builtin_amdgcn_s_sleep(1);
        if ((++sp & 255u) == 0u) { if (xb_ld(&bar[XB_TMO])) break; if (sp > XB_SPIN_CAP) { atomicAdd(&bar[XB_TMO], 1u); break; } }
    }
    nloc = mine > 0u ? mine : 1u; nx = cnt > 0u ? cnt : 1u;
}
__device__ __forceinline__ void xcd_barrier(const XcdBarrier& b, unsigned* bar) {
    asm volatile("s_waitcnt vmcnt(0)" ::: "memory");
    __syncthreads();
    if (threadIdx.x == 0) {
        __builtin_amdgcn_s_waitcnt(0);
        unsigned nloc = b.st[0], nx = b.st[1];
        if (nloc == 0u) { xcd_barrier_complete(bar, b.x, nloc, nx); b.st[0] = nloc; b.st[1] = nx; }
        const unsigned old = xb_add(&bar[XB_XSUB(b.x)], 1u);
        const unsigned gen = old / nloc;
        if (old + 1u == (gen + 1u) * nloc) {
            __builtin_amdgcn_fence(__ATOMIC_RELEASE, "agent");
            asm volatile("s_waitcnt vmcnt(0)" ::: "memory");
            const unsigned og = xb_add(&bar[XB_TOP], 1u);
            const unsigned tg = og / nx;
            if (og + 1u == (tg + 1u) * nx) xb_add(&bar[XB_TOPGEN], 1u);
            else XB_SPIN(xb_ld(&bar[XB_TOPGEN]) == tg, bar);
            __builtin_amdgcn_fence(__ATOMIC_ACQUIRE, "agent");
            xb_add(&bar[XB_XGEN(b.x)], 1u);
            asm volatile("s_waitcnt vmcnt(0)" ::: "memory");
        } else {
            XB_SPIN(xb_ld(&bar[XB_XGEN(b.x)]) == gen, bar);
            __builtin_amdgcn_fence(__ATOMIC_ACQUIRE, "agent");
            asm volatile("s_waitcnt vmcnt(0)" ::: "memory");
        }
    }
    __syncthreads();
}

template <int PH>
__device__ __forceinline__ void do_phase(const Params& p, const int l, LAS unsigned char* lds) {
    const int G = gridDim.x, cb = blockIdx.x;
    unsigned char* ws = p.ws;
    float* MOD = (float*)(ws + OFF_MOD);
    float* XB = (float*)(ws + OFF_XB);
    bf16_t* HX = (bf16_t*)(ws + OFF_HX);
    const float* modl = MOD + l * 3 * 12288;
    const float* srcL = (l == 0) ? p.x : XB;
    const float* srcC = (l == 0) ? p.ctx : XB + (size_t)ML * 2048;
    const int Mx = (l == 0) ? MT : ML;
    if constexpr (PH == 0) { phase_mod(p, lds); __syncthreads(); phase_convert(p, 0, lds, 0, 3328, cb, G); }
    if constexpr (PH == 1) { build_wx1(p, l); build_wx2(p, l);
        phase_norm(srcL, srcC, p.norm_mix_w + l * 2048, modl, 0, 2048, HX, MT, (const float*)(ws + OFF_PREP), (l == 1) ? 16 : 0, MOD + 2 * 12288 + 5 * 2048, nullptr); }
    if constexpr (PH == 2) { pg8::Gemm g{HX, (const bf16_t*)(ws + OFF_WIN), MT, INP, 2048, 2048, 2048}; pg8::Sched S; S.init(MT, INP, G, cb, 1);
        pg8::EpiB16<0, INP> E{(bf16_t*)(ws + OFF_U), nullptr}; pg8::gemm_phase(lds, g, S, E); }
    if constexpr (PH == 13) { build_ax1(p); build_xc(p, l); build_kk_la(p, l); }
    if constexpr (PH == 14) { pg8::Gemm g{(const bf16_t*)(ws + OFF_AX1), (const bf16_t*)(ws + OFF_WX1), MT, 2560, 384, 384, 384}; pg8::Sched S; S.init(MT, 2560, G, cb, 1);
        pg8::EpiRWX E{(bf16_t*)(ws + OFF_LW), (bf16_t*)(ws + OFF_AA), (bf16_t*)(ws + OFF_GV), p.rw_w0 + l * 1024, p.rw_a0 + l * 1024}; pg8::gemm_phase(lds, g, S, E); }
    if constexpr (PH == 15) { pg8::Gemm g{(const bf16_t*)(ws + OFF_XC), (const bf16_t*)(ws + OFF_WX2), MT, 2048, 512, 512, 512}; pg8::Sched S; S.init(MT, 2048, G, cb, 1);
        pg8::EpiGate E{(bf16_t*)(ws + OFF_GATES), p.lru_b_a + l * 1024, p.lru_b_x + l * 1024}; pg8::gemm_phase(lds, g, S, E); }
    if constexpr (PH == 16) phase_prep(p, l, lds, 1);
    if constexpr (PH == 3) phase_prep(p, l, lds, 2);
    if constexpr (PH == 4) phase_scan(p, l, lds);
#ifdef SCAN_PROBE_MASK
    if constexpr (PH == 14) phase_scan(p, l, lds, SCAN_PROBE_MASK);
#endif
    if constexpr (PH == 5) phase_post(p, l, lds);
    if constexpr (PH == 6) { pg8::Gemm g{HX, (const bf16_t*)(ws + OFF_WGT), Mx, 8192, 2048, 2048, 2048}; pg8::Sched S; S.init(Mx, 8192, G, cb, 1);
        pg8::EpiB16<1, 8192> E{(bf16_t*)(ws + OFF_G), p.gate_b + l * 8192}; pg8::gemm_phase(lds, g, S, E); }
    if constexpr (PH == 7) { pg8::Gemm g{(const bf16_t*)(ws + OFF_YS), (const bf16_t*)(ws + OFF_WBR), Mx, 2048, 512, 2048, 512}; pg8::Sched S; S.init(Mx, 2048, G, cb, 4);
        pg8::EpiBr E{(const bf16_t*)(ws + OFF_G), (bf16_t*)(ws + OFF_ACC)}; pg8::gemm_phase(lds, g, S, E); }
    if constexpr (PH == 8) { { pg8::Gemm g{(const bf16_t*)(ws + OFF_ACC), (const bf16_t*)(ws + OFF_WOUT), ML, 2048, 2048, 2048, 2048}; pg8::Sched S; S.init(ML, 2048, G, cb, 1);
          pg8::EpiRes E{srcL, srcC, XB, modl, 2 * 2048}; pg8::gemm_phase(lds, g, S, E); }
        if (l == 0) { __syncthreads(); pg8::Gemm g{(const bf16_t*)(ws + OFF_ACC), (const bf16_t*)(ws + OFF_WOUT), MT, 2048, 256, 2048, 2048}; pg8::Sched S; S.init_split(64, 2, 2048, 8, 256, G, cb);
          pg8::EpiPart E{(float*)(ws + OFF_PREP), 256}; pg8::gemm_phase(lds, g, S, E); } }
    if constexpr (PH == 9) phase_norm(XB, (l == 0) ? p.ctx : XB + (size_t)ML * 2048, p.norm_ffn_w + l * 2048, modl, 3 * 2048, 4 * 2048, HX, Mx, (const float*)(ws + OFF_PREP), (l == 0) ? 8 : 0, modl + 2 * 12288 + 2 * 2048, XB);
    if constexpr (PH == 10) { pg8::Gemm g{HX, (const bf16_t*)(ws + OFF_W1), Mx, 8192, 2048, 2048, 2048}; pg8::Sched S; S.init(Mx, 8192, G, cb, 1);
        pg8::EpiB16<2, 8192> E{(bf16_t*)(ws + OFF_F), nullptr}; pg8::gemm_phase(lds, g, S, E); }
    if constexpr (PH == 11) { { pg8::Gemm g{(const bf16_t*)(ws + OFF_F), (const bf16_t*)(ws + OFF_W2), ML, 2048, 8192, 8192, 8192}; pg8::Sched S; S.init(ML, 2048, G, cb, 1);
          pg8::EpiRes E{XB, XB + (size_t)ML * 2048, XB, modl, 5 * 2048}; pg8::gemm_phase(lds, g, S, E); }
        if (l == 0) { __syncthreads(); pg8::Gemm g{(const bf16_t*)(ws + OFF_F), (const bf16_t*)(ws + OFF_W2), MT, 2048, 512, 8192, 8192}; pg8::Sched S; S.init_split(64, 2, 2048, 16, 512, G, cb);
          pg8::EpiPart E{(float*)(ws + OFF_PREP), 512}; pg8::gemm_phase(lds, g, S, E); } }
    if constexpr (PH == 12) phase_final_norm(XB, p.final_norm_w, p.out);
}

#ifndef SINGLE_LAUNCH
#define SINGLE_LAUNCH 1
#endif

#if SINGLE_LAUNCH
__global__ void __launch_bounds__(512, 2) mega(Params p) {
    extern __shared__ __attribute__((aligned(16))) unsigned char smem[];
    LAS unsigned char* lds = (LAS unsigned char*)smem;
    cg::grid_group grid = cg::this_grid();
    volatile LAS unsigned* bst = (volatile LAS unsigned*)(lds + LDS_BYTES - 16);
    if (threadIdx.x < 4) bst[threadIdx.x] = 0u;
    __syncthreads();
    const XcdBarrier xbar = xcd_barrier_post((unsigned*)(p.ws + OFF_BAR), bst);
#ifndef DBL_MASK
#define DBL_MASK 0
#endif
#define RUNPH(ph, l) do { do_phase<ph>(p, l, lds); xcd_barrier(xbar, (unsigned*)(p.ws + OFF_BAR)); if (DBL_MASK & (1 << (ph))) { do_phase<ph>(p, l, lds); xcd_barrier(xbar, (unsigned*)(p.ws + OFF_BAR)); } } while (0)
    if (p.ws == nullptr) grid.sync();
    do_phase<0>(p, 0, lds); xcd_barrier(xbar, (unsigned*)(p.ws + OFF_BAR));
    for (int l = 0; l < 2; ++l) {
        RUNPH(1, l); RUNPH(2, l); RUNPH(13, l); do_phase<14>(p, l, lds); __syncthreads(); do_phase<15>(p, l, lds); xcd_barrier(xbar, (unsigned*)(p.ws + OFF_BAR)); RUNPH(3, l); RUNPH(4, l);
#ifdef SCAN_PROBE_MASK
        do_phase<14>(p, l, lds); xcd_barrier(xbar, (unsigned*)(p.ws + OFF_BAR));
#endif
        RUNPH(5, l); RUNPH(6, l); RUNPH(7, l); RUNPH(8, l); RUNPH(9, l); RUNPH(10, l); RUNPH(11, l);
    }
    do_phase<12>(p, 0, lds);
}
#else
template <int PH> __global__ void __launch_bounds__(512, 2) k_phase(Params p, int l) {
    extern __shared__ __attribute__((aligned(16))) unsigned char smem[];
    do_phase<PH>(p, l, (LAS unsigned char*)smem);
}
template <int PH> static void launch_phase(const Params& p, int l, int grid, hipStream_t stream) {
    static bool attr = false;
    if (!attr) { (void)hipFuncSetAttribute((const void*)k_phase<PH>, hipFuncAttributeMaxDynamicSharedMemorySize, LDS_BYTES); attr = true; }
    hipLaunchKernelGGL(k_phase<PH>, dim3(grid), dim3(512), LDS_BYTES, stream, p, l);
}
#endif

extern "C" void kernel_launch(void* const* d_in, const int* in_sizes, int n_in, void* d_out, int out_size, void* d_ws, size_t ws_size, hipStream_t stream) {
    static int grid_blocks = 0;
    if (grid_blocks == 0) {
        if (n_in != 38 || ws_size < WS_END) { fprintf(stderr, "kernel_launch: need 38 inputs and >= %zu bytes of workspace (got %d, %zu)\n", (size_t)WS_END, n_in, ws_size); grid_blocks = -1; return; }
        int dev = 0, cus = 0;
        (void)hipGetDevice(&dev);
        (void)hipDeviceGetAttribute(&cus, hipDeviceAttributeMultiprocessorCount, dev);
#if SINGLE_LAUNCH
        int per_cu = 0;
        if (hipFuncSetAttribute((const void*)mega, hipFuncAttributeMaxDynamicSharedMemorySize, LDS_BYTES) != hipSuccess) { fprintf(stderr, "kernel_launch: hipFuncSetAttribute failed\n"); grid_blocks = -1; return; }
        if (hipOccupancyMaxActiveBlocksPerMultiprocessor(&per_cu, (const void*)mega, 512, LDS_BYTES) != hipSuccess || per_cu < 1) { fprintf(stderr, "kernel_launch: occupancy query says %d blocks per CU\n", per_cu); (void)hipGetLastError(); per_cu = 1; }
        grid_blocks = cus * per_cu;
#else
        grid_blocks = cus;
#endif
    }
    if (grid_blocks < 0) return;
    Params p{};
    const float** dst = (const float**)&p;
    for (int i = 0; i < 38; ++i) dst[i] = (const float*)d_in[i];
    p.out = (float*)d_out; p.ws = (unsigned char*)d_ws;
#if SINGLE_LAUNCH
    (void)hipMemsetAsync((unsigned char*)d_ws + OFF_BAR, 0, 16384, stream);
    void* args[] = {&p};
    hipError_t e = hipLaunchCooperativeKernel((const void*)mega, dim3(grid_blocks), dim3(512), args, LDS_BYTES, stream);
    if (e != hipSuccess) fprintf(stderr, "cooperative launch failed: %s (grid %d)\n", hipGetErrorString(e), grid_blocks);
#else
    const int g = grid_blocks;
    launch_phase<0>(p, 0, g, stream);
    for (int l = 0; l < 2; ++l) {
        launch_phase<1>(p, l, g, stream); launch_phase<2>(p, l, g, stream); launch_phase<3>(p, l, g, stream); launch_phase<4>(p, l, g, stream);
        launch_phase<5>(p, l, g, stream); launch_phase<6>(p, l, g, stream); launch_phase<7>(p, l, g, stream); launch_phase<8>(p, l, g, stream);
        launch_phase<9>(p, l, g, stream); launch_phase<10>(p, l, g, stream); launch_phase<11>(p, l, g, stream);
    }
    launch_phase<12>(p, 0, g, stream);
#endif
}
```

```cpp
#include <hip/hip_runtime.h>
#include <hip/hip_cooperative_groups.h>
#include <cstdio>
namespace cg = cooperative_groups;

#define LAS __attribute__((address_space(3)))
typedef unsigned short bf16_t;
typedef short bf16x8 __attribute__((ext_vector_type(8)));
typedef float f32x4 __attribute__((ext_vector_type(4)));
typedef float f32x2 __attribute__((ext_vector_type(2)));
typedef unsigned u32x4 __attribute__((ext_vector_type(4)));
typedef unsigned u32x2 __attribute__((ext_vector_type(2)));

constexpr int D = 2048, SEQ = 8192, CTX = 256, DFF = 8192;
constexpr int ML = 2 * SEQ;
constexpr int MC = 2 * CTX;
constexpr int MT = ML + MC;
constexpr int INC = 6576, INP = 6656;
constexpr int C_RW_R = 0, C_RW_K = 512, C_RW_V = 1024, C_RW_W = 1536, C_RW_A = 1664, C_RW_G = 1792, C_LRU_X = 1920, C_LRU_G = 2432,
              C_GLA_Q = 2944, C_GLA_K = 3200, C_GLA_V = 3456, C_GLA_R = 3968, C_GLA_W = 4480, C_ML_Q = 4512, C_ML_K = 5024, C_ML_V = 5536,
              C_ML_O = 6048, C_ML_I = 6560, C_ML_F = 6568;
constexpr float EPS = 1e-6f;
constexpr int LDS_BYTES = 147456;
constexpr int NCH = 264;

constexpr size_t AL(size_t x) { return (x + 255) & ~(size_t)255; }
constexpr size_t OFF_MOD = 0;
constexpr size_t OFF_WIN = AL(OFF_MOD + (size_t)2 * 3 * 12288 * 4);
constexpr size_t OFF_WGT = OFF_WIN + (size_t)INP * 2048 * 2;
constexpr size_t OFF_WBR = OFF_WGT + (size_t)8192 * 2048 * 2;
constexpr size_t OFF_WOUT = OFF_WBR + (size_t)4 * 2048 * 512 * 2;
constexpr size_t OFF_W1 = OFF_WOUT + (size_t)2048 * 2048 * 2;
constexpr size_t OFF_W2 = OFF_W1 + (size_t)8192 * 2048 * 2;
constexpr size_t OFF_XB = OFF_W2 + (size_t)2048 * 8192 * 2;
constexpr size_t OFF_HX = OFF_XB + (size_t)MT * 2048 * 4;
constexpr size_t OFF_BIG = OFF_HX + (size_t)MT * 2048 * 2;
constexpr size_t OFF_U = OFF_BIG;
constexpr size_t SZ_Y = (size_t)2 * MT * 512 * 2;
constexpr size_t OFF_YRW = OFF_U + (size_t)MT * INP * 2;
constexpr size_t OFF_YGL = OFF_YRW + SZ_Y;
constexpr size_t OFF_YML = OFF_YGL + SZ_Y;
constexpr size_t OFF_DEN = OFF_YML + SZ_Y;
constexpr size_t OFF_PREP = AL(OFF_DEN + (size_t)2 * MT * 4 * 4);
constexpr size_t OFF_LW = OFF_PREP;
constexpr size_t OFF_AA = OFF_LW + SZ_Y;
constexpr size_t OFF_NKK = OFF_AA + SZ_Y;
constexpr size_t OFF_LA = OFF_NKK + (size_t)MT * 512 * 2;
constexpr size_t OFF_LACUM = OFF_LA + (size_t)2 * MT * 256 * 2;
constexpr size_t OFF_LHLOC = OFF_LACUM + SZ_Y;
constexpr size_t SZ_LS = (size_t)2 * 2 * NCH * 512 * 4;
constexpr size_t OFF_APROD = OFF_LHLOC + SZ_Y;
constexpr size_t OFF_HEND = OFF_APROD + SZ_LS;
constexpr size_t OFF_CARRY = OFF_HEND + SZ_LS;
constexpr size_t OFF_BAR = OFF_CARRY + SZ_LS;
constexpr size_t OFF_GV = OFF_BAR + 16384;
constexpr size_t OFF_WX1 = OFF_GV + (size_t)MT * 512 * 2;
constexpr size_t OFF_WX2 = OFF_WX1 + (size_t)2560 * 384 * 2;
constexpr size_t WS_END = OFF_WX2 + (size_t)2048 * 512 * 2;
constexpr size_t OFF_XC = OFF_YML + AL((size_t)MT * 384 * 2);
constexpr size_t OFF_GATES = OFF_YRW;
static_assert(OFF_XC + (size_t)MT * 512 * 2 <= OFF_YML + SZ_Y, "XC alias");
constexpr size_t OFF_AX1 = OFF_YML;
constexpr size_t OFF_YS = OFF_PREP;
constexpr size_t OFF_G = OFF_BIG;
constexpr size_t OFF_ACC = OFF_HX;
constexpr size_t OFF_F = OFF_BIG;
static_assert(OFF_YS + (size_t)MT * 2048 * 2 <= OFF_LACUM, "YS alias");
static_assert(OFF_G + (size_t)MT * 8192 * 2 <= OFF_PREP, "G alias");

struct Params {
    const float *x, *c, *ctx, *c_ctx, *ada_w, *ada_b, *norm_mix_w, *w_in, *rw_w_up, *rw_w0, *rw_a_up, *rw_a0, *rw_g_up, *rw_k_k, *rw_k_a, *rw_r_k, *rw_ln_w,
        *lru_conv_w, *lru_conv_b, *lru_w_a, *lru_b_a, *lru_w_x, *lru_b_x, *lru_lambda, *gla_w_up, *gla_w0, *gla_ln_w, *ml_i_b, *ml_f_b, *ml_ln_w,
        *br_w, *gate_w, *gate_b, *out_w, *norm_ffn_w, *ffn_w1, *ffn_w2, *final_norm_w;
    float* out;
    unsigned char* ws;
};

__device__ __forceinline__ int otid() { int t = threadIdx.x; asm volatile("" : "+v"(t)); return t; }
__device__ __forceinline__ float bf2f(bf16_t v) { return __uint_as_float(((unsigned)v) << 16); }
__device__ __forceinline__ unsigned cvt_pk_bf16(float lo, float hi) { unsigned r; asm("v_cvt_pk_bf16_f32 %0, %1, %2" : "=v"(r) : "v"(lo), "v"(hi)); return r; }
__device__ __forceinline__ bf16_t f2bf(float x) { return (bf16_t)(cvt_pk_bf16(x, 0.f) & 0xffffu); }
__device__ __forceinline__ float sigm(float x) { return 1.0f / (1.0f + __expf(-x)); }
__device__ __forceinline__ float sigm_fast(float x) { const float d = 1.0f + __expf(-x); float r; asm volatile("s_nop 1\n\tv_rcp_f32 %0, %1\n\ts_nop 1" : "=&v"(r) : "v"(d)); return r; }
__device__ __forceinline__ float tanh_(float x) { const float t = __expf(2.0f * x); return 1.0f - 2.0f / (t + 1.0f); }
__device__ __forceinline__ float gelu_tanh(float x) { return 0.5f * x * (1.0f + tanh_(0.7978845608028654f * (x + 0.044715f * x * x * x))); }
__device__ __forceinline__ float log_sigm(float x) { return fminf(x, 0.f) - log1pf(__expf(-fabsf(x))); }
__device__ __forceinline__ float softplus_(float y) { return fmaxf(y, 0.f) + log1pf(__expf(-fabsf(y))); }
template <int CTRL> __device__ __forceinline__ float dppmov(float x) { return __int_as_float(__builtin_amdgcn_update_dpp(0, __float_as_int(x), CTRL, 0xF, 0xF, true)); }
__device__ __forceinline__ float red16(float x) {
    x += dppmov<0xB1>(x); x += dppmov<0x4E>(x); x += dppmov<0x141>(x); x += dppmov<0x140>(x); return x;
}
__device__ __forceinline__ float red8(float x) { x += dppmov<0xB1>(x); x += dppmov<0x4E>(x); x += dppmov<0x141>(x); return x; }
__device__ __forceinline__ float wave_sum(float v) {
    v = red16(v);
    const float a = __int_as_float(__builtin_amdgcn_readlane(__float_as_int(v), 0)), b = __int_as_float(__builtin_amdgcn_readlane(__float_as_int(v), 16)),
                c = __int_as_float(__builtin_amdgcn_readlane(__float_as_int(v), 32)), d = __int_as_float(__builtin_amdgcn_readlane(__float_as_int(v), 48));
    return (a + b) + (c + d);
}
__device__ __forceinline__ void unpack4(const u32x2 w, float (&f)[4]) { f[0] = __uint_as_float(w.x << 16); f[1] = __uint_as_float(w.x & 0xffff0000u); f[2] = __uint_as_float(w.y << 16); f[3] = __uint_as_float(w.y & 0xffff0000u); }
__device__ __forceinline__ void unpack8(const u32x4 w, float (&f)[8]) {
    f[0] = __uint_as_float(w.x << 16); f[1] = __uint_as_float(w.x & 0xffff0000u); f[2] = __uint_as_float(w.y << 16); f[3] = __uint_as_float(w.y & 0xffff0000u);
    f[4] = __uint_as_float(w.z << 16); f[5] = __uint_as_float(w.z & 0xffff0000u); f[6] = __uint_as_float(w.w << 16); f[7] = __uint_as_float(w.w & 0xffff0000u);
}
__device__ __forceinline__ u32x4 pack8(const float (&f)[8]) { u32x4 w; w.x = cvt_pk_bf16(f[0], f[1]); w.y = cvt_pk_bf16(f[2], f[3]); w.z = cvt_pk_bf16(f[4], f[5]); w.w = cvt_pk_bf16(f[6], f[7]); return w; }

namespace pg8 {
constexpr int BM = 256, BK = 64, HALF = 128, HTB = HALF * BK * 2, STAGE_BYTES = 8 * HTB, NXCD = 8, WGM = 8;
__device__ __forceinline__ int lds_byte(int r, int c) { const int st = (r >> 4) * 2 + (c >> 5), rr = r & 15, cc = c & 31, ob = rr * 64 + cc * 2; return st * 1024 + (ob ^ (((ob >> 9) & 1) << 5)); }
__device__ __forceinline__ void stage_rc(int b, int& R, int& C) { const int st = b / 1024, sb = b % 1024, swz = sb ^ (((sb >> 9) & 1) << 5); R = (st >> 1) * 16 + swz / 64; C = (st & 1) * 32 + (swz % 64) / 2; }
__device__ __forceinline__ int perm32(int rho) { const int n = rho >> 4, i = rho & 15; return 8 * (i >> 2) + 4 * n + (i & 3); }

struct Unit { int pm, pn, pb, ak, br, bk; };
struct Gemm { const bf16_t* A; const bf16_t* Bt; int M, N, K, lda, ldb; };
struct Sched {
    int nM, nN, nwg, G, c, grp, split, pm0, ksub;
    __device__ void init(int M, int N, int G_, int c_, int grp_) { nM = M / BM; nN = N / BM; nwg = nM * nN; G = G_; c = c_; grp = grp_; split = 0; pm0 = 0; ksub = 0; }
    __device__ void init_split(int pm0_, int nMt, int N, int S, int ksub_, int G_, int c_) { nM = nMt; nN = N / BM; nwg = nMt * nN * S; G = G_; c = c_; grp = 1; split = S; pm0 = pm0_; ksub = ksub_; }
    __device__ bool next(int i, Unit& u) const {
        const int q = (grp == 4) ? (i >> 2) : i, br = (grp == 4) ? (i & 3) : 0;
        const long L = (long)q * G + c; if (L >= nwg) return false;
        if (split) { const int ks = (int)L % split, tile = (int)L / split; u.pm = pm0 + tile / nN; u.pn = tile % nN; u.pb = u.pn; u.ak = ks * ksub; u.bk = u.ak; u.br = 0; return true; }
        int wgid = (int)L; { const int qq = nwg / NXCD, r = nwg % NXCD, xcd = wgid % NXCD, off = wgid / NXCD; wgid = (xcd < r ? xcd * (qq + 1) : r * (qq + 1) + (xcd - r) * qq) + off; }
        const int nig = WGM * nN, gid = wgid / nig, fm = gid * WGM, gsz = (nM - fm) < WGM ? (nM - fm) : WGM;
        u.pm = fm + ((wgid % nig) % gsz); u.pn = (wgid % nig) / gsz; u.br = br; u.pb = br * nN + u.pn; u.ak = br * 512; u.bk = 0; return true;
    }
};

template <class Epi>
__device__ __forceinline__ void gemm_phase(LAS unsigned char* lds, const Gemm g, const Sched& S, const Epi& E) {
    const int tid = otid(), wid = __builtin_amdgcn_readfirstlane(tid >> 6), lane = tid & 63, wr = wid >> 2, wc = wid & 3, fr = lane & 15, fq = lane >> 4;
    int nt = g.K / BK; asm volatile("" : "+s"(nt));
    unsigned voffA[2], voffB[2];
#pragma unroll
    for (int i = 0; i < 2; ++i) { int R, C; stage_rc(tid * 16 + i * 8192, R, C); const int Rb = Epi::PERM ? ((R & ~31) + perm32(R & 31)) : R;
        voffA[i] = (unsigned)(R * g.lda + C) * 2u; voffB[i] = (unsigned)(Rb * g.ldb + C) * 2u; }
    const size_t kstep = (size_t)(BK * 2);
    const size_t hstepA = (size_t)HALF * g.lda * 2, hstepB = (size_t)HALF * g.ldb * 2;
    const unsigned ldsw = (unsigned)wid * 1024u;
    const int aoff = lds_byte(wr * 64 + fr, fq * 8), boff = lds_byte(wc * 32 + fr, fq * 8);
#define PG8_SA(b, h) (((b) * 2 + (h)) * HTB)
#define PG8_SB(b, h) ((4 + (b) * 2 + (h)) * HTB)
#define PG8_STAGE(bufoff, gbase, voff) do { _Pragma("unroll") for (int _i = 0; _i < 2; ++_i) \
        __builtin_amdgcn_global_load_lds((const unsigned*)((const char*)(gbase) + (voff)[_i]), (LAS unsigned*)(lds + (bufoff) + ldsw + _i * 8192), 16, 0, 0); } while (0)
#define PG8_LDA(dst, b, h) do { _Pragma("unroll") for (int m = 0; m < 4; ++m) _Pragma("unroll") for (int k = 0; k < 2; ++k) dst[m][k] = *(const LAS bf16x8*)(lds + PG8_SA(b, h) + aoff + m * 2048 + k * 1024); } while (0)
#define PG8_LDB(dst, b, h) do { _Pragma("unroll") for (int n = 0; n < 2; ++n) _Pragma("unroll") for (int k = 0; k < 2; ++k) dst[n][k] = *(const LAS bf16x8*)(lds + PG8_SB(b, h) + boff + n * 2048 + k * 1024); } while (0)
#define PG8_MMA(ai, bj, At, Bt) do { __builtin_amdgcn_s_setprio(1); _Pragma("unroll") for (int m = 0; m < 4; ++m) _Pragma("unroll") for (int n = 0; n < 2; ++n) _Pragma("unroll") for (int k = 0; k < 2; ++k) \
        acc[ai][bj][m][n] = __builtin_amdgcn_mfma_f32_16x16x32_bf16(Bt[n][k], At[m][k], acc[ai][bj][m][n], 0, 0, 0); __builtin_amdgcn_s_setprio(0); } while (0)
#define PG8_WAIT_V(n) asm volatile("s_waitcnt vmcnt(" #n ")" ::: "memory")
#define PG8_WAIT_L(n) asm volatile("s_waitcnt lgkmcnt(" #n ")" ::: "memory")
#define PG8_BAR __builtin_amdgcn_s_barrier()
#define PG8_SCHED __builtin_amdgcn_sched_barrier(0)
    Unit cur, nxt; int ui = 0;
    if (!S.next(0, cur)) return;
    f32x4 acc[2][2][4][2];
#pragma unroll
    for (int a = 0; a < 2; ++a)
#pragma unroll
        for (int b = 0; b < 2; ++b)
#pragma unroll
            for (int m = 0; m < 4; ++m)
#pragma unroll
                for (int n = 0; n < 2; ++n) acc[a][b][m][n] = (f32x4){0.f, 0.f, 0.f, 0.f};
    bf16x8 At[4][2], B0[2][2], B1[2][2];
    const char* cA = (const char*)g.A + (size_t)cur.pm * 2 * hstepA + (size_t)cur.ak * 2;
    const char* cB = (const char*)g.Bt + (size_t)cur.pb * 2 * hstepB + (size_t)cur.bk * 2;
    PG8_STAGE(PG8_SB(0, 0), cB, voffB); PG8_STAGE(PG8_SA(0, 0), cA, voffA); PG8_STAGE(PG8_SB(0, 1), cB + hstepB, voffB); PG8_STAGE(PG8_SA(0, 1), cA + hstepA, voffA);
    if (wr == 1) PG8_BAR;
    PG8_WAIT_V(4); PG8_BAR;
    PG8_STAGE(PG8_SB(1, 0), cB + kstep, voffB); PG8_STAGE(PG8_SA(1, 0), cA + kstep, voffA); PG8_STAGE(PG8_SB(1, 1), cB + hstepB + kstep, voffB);
    PG8_WAIT_V(6); PG8_BAR;
    for (;;) {
        const bool has_next = S.next(ui + 1, nxt);
        const char* nA = has_next ? (const char*)g.A + (size_t)nxt.pm * 2 * hstepA + (size_t)nxt.ak * 2 : cA;
        const char* nB = has_next ? (const char*)g.Bt + (size_t)nxt.pb * 2 * hstepB + (size_t)nxt.bk * 2 : cB;
        for (int t = 0; t < nt; t += 2) {
            const bool last = (t == nt - 2);
            const char* a1 = cA + (size_t)(t + 1) * kstep;
            const char* a2 = last ? nA : cA + (size_t)(t + 2) * kstep; const char* b2 = last ? nB : cB + (size_t)(t + 2) * kstep;
            const char* a3 = a2 + kstep; const char* b3 = b2 + kstep;
            PG8_LDB(B0, 0, 0); PG8_SCHED; PG8_LDA(At, 0, 0); PG8_STAGE(PG8_SA(1, 1), a1 + hstepA, voffA);
            PG8_WAIT_L(8); PG8_BAR; PG8_WAIT_L(0); PG8_MMA(0, 0, At, B0); PG8_BAR; PG8_SCHED;
            PG8_LDB(B1, 0, 1); PG8_STAGE(PG8_SB(0, 0), b2, voffB);
            PG8_BAR; PG8_WAIT_L(0); PG8_MMA(0, 1, At, B1); PG8_BAR;
            PG8_LDA(At, 0, 1); PG8_STAGE(PG8_SA(0, 0), a2, voffA);
            PG8_BAR; PG8_WAIT_L(0); PG8_MMA(1, 0, At, B0); PG8_BAR; PG8_SCHED;
            PG8_STAGE(PG8_SB(0, 1), b2 + hstepB, voffB);
            PG8_WAIT_V(6); PG8_BAR; PG8_MMA(1, 1, At, B1); PG8_BAR;
            PG8_LDB(B0, 1, 0); PG8_SCHED; PG8_LDA(At, 1, 0); PG8_STAGE(PG8_SA(0, 1), a2 + hstepA, voffA);
            PG8_WAIT_L(8); PG8_BAR; PG8_WAIT_L(0); PG8_MMA(0, 0, At, B0); PG8_BAR; PG8_SCHED;
            PG8_LDB(B1, 1, 1); PG8_STAGE(PG8_SB(1, 0), b3, voffB);
            PG8_BAR; PG8_WAIT_L(0); PG8_MMA(0, 1, At, B1); PG8_BAR;
            PG8_LDA(At, 1, 1); PG8_STAGE(PG8_SA(1, 0), a3, voffA);
            PG8_BAR; PG8_WAIT_L(0); PG8_MMA(1, 0, At, B0); PG8_BAR; PG8_SCHED;
            PG8_STAGE(PG8_SB(1, 1), b3 + hstepB, voffB);
            PG8_WAIT_V(6); PG8_BAR; PG8_MMA(1, 1, At, B1); PG8_BAR;
        }
        const bool keep = E(acc, cur, wr, wc, fr, fq);
        if (!has_next) break;
        if (!keep) {
#pragma unroll
            for (int a = 0; a < 2; ++a)
#pragma unroll
                for (int b = 0; b < 2; ++b)
#pragma unroll
                    for (int m = 0; m < 4; ++m)
#pragma unroll
                        for (int n = 0; n < 2; ++n) acc[a][b][m][n] = (f32x4){0.f, 0.f, 0.f, 0.f};
        }
        cur = nxt; cA = nA; cB = nB; ++ui;
    }
    PG8_WAIT_V(0);
    if (wr == 0) PG8_BAR;
    PG8_BAR;
#undef PG8_SA
#undef PG8_SB
#undef PG8_STAGE
#undef PG8_LDA
#undef PG8_LDB
#undef PG8_MMA
#undef PG8_WAIT_V
#undef PG8_WAIT_L
#undef PG8_BAR
#undef PG8_SCHED
}

template <int ACT  , int ldc> struct EpiB16 {
    static constexpr bool PERM = true;
    bf16_t* O; const float* bias;
    __device__ __forceinline__ bool operator()(f32x4 (&acc)[2][2][4][2], const Unit& u, int wr, int wc, int fr, int fq) const {
        const int row0 = u.pm * BM + wr * 64 + fr, col0 = u.pn * BM + wc * 32 + 8 * fq;
        f32x4 bv[2][2];
#pragma unroll
        for (int bj = 0; bj < 2; ++bj)
#pragma unroll
            for (int n = 0; n < 2; ++n) bv[bj][n] = (ACT == 1) ? *(const f32x4*)(bias + col0 + bj * HALF + 4 * n) : (f32x4){0.f, 0.f, 0.f, 0.f};
#pragma unroll
        for (int ai = 0; ai < 2; ++ai)
#pragma unroll
            for (int m = 0; m < 4; ++m) { bf16_t* rowp = O + (size_t)(row0 + ai * HALF + m * 16) * ldc + col0;
#pragma unroll
                for (int bj = 0; bj < 2; ++bj) { f32x4 v0 = acc[ai][bj][m][0], v1 = acc[ai][bj][m][1];
                    if (ACT == 1) {
                        v0 += bv[bj][0]; v1 += bv[bj][1];
#pragma unroll
                        for (int j = 0; j < 4; ++j) { v0[j] = sigm_fast(v0[j]); v1[j] = sigm_fast(v1[j]); } }
                    if (ACT == 2) {
#pragma unroll
                        for (int j = 0; j < 4; ++j) { const float a = fmaxf(v0[j], 0.f), b = fmaxf(v1[j], 0.f); v0[j] = a * a; v1[j] = b * b; } }
                    u32x4 w; w.x = cvt_pk_bf16(v0[0], v0[1]); w.y = cvt_pk_bf16(v0[2], v0[3]); w.z = cvt_pk_bf16(v1[0], v1[1]); w.w = cvt_pk_bf16(v1[2], v1[3]);
                    *(u32x4*)(rowp + bj * HALF) = w; } }
        return false;
    }
};
struct EpiRWX {
    static constexpr bool PERM = true;
    bf16_t* LWp; bf16_t* AAp; bf16_t* GVp; const float* w0; const float* a0;
    __device__ __forceinline__ bool operator()(f32x4 (&acc)[2][2][4][2], const Unit& u, int wr, int wc, int fr, int fq) const {
        const int row0 = u.pm * BM + wr * 64 + fr, t = u.pn >> 1, cc0 = (u.pn & 1) * 256 + wc * 32 + 8 * fq, z = t & 1;
        const float* bias = (t < 2) ? w0 + z * 512 : a0 + z * 512;
        bf16_t* base = (t < 2) ? LWp + (size_t)z * MT * 512 : ((t < 4) ? AAp + (size_t)z * MT * 512 : GVp);
        f32x4 bv[2][2];
#pragma unroll
        for (int bj = 0; bj < 2; ++bj)
#pragma unroll
            for (int n = 0; n < 2; ++n) bv[bj][n] = (t < 4) ? *(const f32x4*)(bias + cc0 + bj * HALF + 4 * n) : (f32x4){0.f, 0.f, 0.f, 0.f};
        const float sc = (t < 2) ? -0.6065306597f : 1.0f;
#pragma unroll
        for (int ai = 0; ai < 2; ++ai)
#pragma unroll
            for (int m = 0; m < 4; ++m) { bf16_t* rowp = base + (size_t)(row0 + ai * HALF + m * 16) * 512 + cc0;
#pragma unroll
                for (int bj = 0; bj < 2; ++bj) { f32x4 v0 = acc[ai][bj][m][0] + bv[bj][0], v1 = acc[ai][bj][m][1] + bv[bj][1];
                    if (t < 4) {
#pragma unroll
                        for (int j = 0; j < 4; ++j) { v0[j] = sc * sigm_fast(v0[j]); v1[j] = sc * sigm_fast(v1[j]); } }
                    u32x4 w; w.x = cvt_pk_bf16(v0[0], v0[1]); w.y = cvt_pk_bf16(v0[2], v0[3]); w.z = cvt_pk_bf16(v1[0], v1[1]); w.w = cvt_pk_bf16(v1[2], v1[3]);
                    *(u32x4*)(rowp + bj * HALF) = w; } }
        return false;
    }
};
struct EpiGate {
    static constexpr bool PERM = true;
    bf16_t* O; const float* ba; const float* bx;
    __device__ __forceinline__ bool operator()(f32x4 (&acc)[2][2][4][2], const Unit& u, int wr, int wc, int fr, int fq) const {
        const int row0 = u.pm * BM + wr * 64 + fr, gz = u.pn >> 1, cc0 = (u.pn & 1) * 256 + wc * 32 + 8 * fq;
        const float* bias = ((gz >> 1) ? bx : ba) + (gz & 1) * 512;
        bf16_t* base = O + (size_t)gz * MT * 512;
        f32x4 bv[2][2];
#pragma unroll
        for (int bj = 0; bj < 2; ++bj)
#pragma unroll
            for (int n = 0; n < 2; ++n) bv[bj][n] = *(const f32x4*)(bias + cc0 + bj * HALF + 4 * n);
#pragma unroll
        for (int ai = 0; ai < 2; ++ai)
#pragma unroll
            for (int m = 0; m < 4; ++m) { bf16_t* rowp = base + (size_t)(row0 + ai * HALF + m * 16) * 512 + cc0;
#pragma unroll
                for (int bj = 0; bj < 2; ++bj) { f32x4 v0 = acc[ai][bj][m][0] + bv[bj][0], v1 = acc[ai][bj][m][1] + bv[bj][1];
#pragma unroll
                    for (int j = 0; j < 4; ++j) { v0[j] = sigm_fast(v0[j]); v1[j] = sigm_fast(v1[j]); }
                    u32x4 w; w.x = cvt_pk_bf16(v0[0], v0[1]); w.y = cvt_pk_bf16(v0[2], v0[3]); w.z = cvt_pk_bf16(v1[0], v1[1]); w.w = cvt_pk_bf16(v1[2], v1[3]);
                    *(u32x4*)(rowp + bj * HALF) = w; } }
        return false;
    }
};
struct EpiRes {
    static constexpr bool PERM = false;
    const float* srcL; const float* srcC; float* dst; const float* modl; int goff;
    __device__ __forceinline__ bool operator()(f32x4 (&acc)[2][2][4][2], const Unit& u, int wr, int wc, int fr, int fq) const {
        const int row0 = u.pm * BM + wr * 64 + fr, col0 = u.pn * BM + wc * 32 + 4 * fq;
        const int r = (u.pm < 64) ? (u.pm >> 5) : 2;
        const float* gp = modl + r * 12288 + goff + col0;
        f32x4 gv[2][2];
#pragma unroll
        for (int bj = 0; bj < 2; ++bj)
#pragma unroll
            for (int n = 0; n < 2; ++n) gv[bj][n] = *(const f32x4*)(gp + bj * HALF + n * 16);
#pragma unroll
        for (int ai = 0; ai < 2; ++ai)
#pragma unroll
            for (int m = 0; m < 4; ++m) { const int row = row0 + ai * HALF + m * 16;
                const float* sp = ((row < ML) ? srcL + (size_t)row * 2048 : srcC + (size_t)(row - ML) * 2048) + col0; float* dp = dst + (size_t)row * 2048 + col0;
#pragma unroll
                for (int bj = 0; bj < 2; ++bj)
#pragma unroll
                    for (int n = 0; n < 2; ++n) { const f32x4 xo = *(const f32x4*)(sp + bj * HALF + n * 16); *(f32x4*)(dp + bj * HALF + n * 16) = xo + gv[bj][n] * acc[ai][bj][m][n]; }
                asm volatile("" ::: "memory"); }
        return false;
    }
};
struct EpiPart {
    static constexpr bool PERM = false;
    float* part; int ksub;
    __device__ __forceinline__ bool operator()(f32x4 (&acc)[2][2][4][2], const Unit& u, int wr, int wc, int fr, int fq) const {
        const int row0 = u.pm * BM + wr * 64 + fr - ML, col0 = u.pn * BM + wc * 32 + 4 * fq, ks = u.ak / ksub;
#pragma unroll
        for (int ai = 0; ai < 2; ++ai)
#pragma unroll
            for (int m = 0; m < 4; ++m) { float* dp = part + ((size_t)ks * MC + (row0 + ai * HALF + m * 16)) * 2048 + col0;
#pragma unroll
                for (int bj = 0; bj < 2; ++bj)
#pragma unroll
                    for (int n = 0; n < 2; ++n) *(f32x4*)(dp + bj * HALF + n * 16) = acc[ai][bj][m][n]; }
        return false;
    }
};
struct EpiBr {
    static constexpr bool PERM = true;
    const bf16_t* G; bf16_t* O;
    __device__ __forceinline__ bool operator()(f32x4 (&acc)[2][2][4][2], const Unit& u, int wr, int wc, int fr, int fq) const {
        const int row0 = u.pm * BM + wr * 64 + fr, col0 = u.pn * BM + wc * 32 + 8 * fq;
        const bool lastb = (u.br == 3);
#pragma unroll
        for (int ai = 0; ai < 2; ++ai)
#pragma unroll
            for (int m = 0; m < 4; ++m) { const size_t row = (size_t)(row0 + ai * HALF + m * 16);
#pragma unroll
                for (int bj = 0; bj < 2; ++bj) {
                    const u32x4 gc = *(const u32x4*)(G + row * 8192 + u.br * 2048 + col0 + bj * HALF);
                    float fc[8]; unpack8(gc, fc);
                    if (!lastb) {
                        const u32x4 gn = *(const u32x4*)(G + row * 8192 + (u.br + 1) * 2048 + col0 + bj * HALF);
                        float fn[8]; unpack8(gn, fn);
#pragma unroll
                        for (int j = 0; j < 8; ++j) fc[j] = fc[j] * __builtin_amdgcn_rcpf(fmaxf(fn[j], 1e-30f));
                    }
                    f32x4 v0 = acc[ai][bj][m][0], v1 = acc[ai][bj][m][1];
#pragma unroll
                    for (int j = 0; j < 4; ++j) { v0[j] *= fc[j]; v1[j] *= fc[4 + j]; }
                    acc[ai][bj][m][0] = v0; acc[ai][bj][m][1] = v1;
                    if (lastb) { u32x4 w; w.x = cvt_pk_bf16(v0[0], v0[1]); w.y = cvt_pk_bf16(v0[2], v0[3]); w.z = cvt_pk_bf16(v1[0], v1[1]); w.w = cvt_pk_bf16(v1[2], v1[3]);
                        *(u32x4*)(O + row * 2048 + col0 + bj * HALF) = w; }
                }
                asm volatile("" ::: "memory"); }
        return !lastb;
    }
};
}

__device__ void phase_mod(const Params& p, LAS unsigned char* lds) {
    LAS float* sl = (LAS float*)lds;
    LAS float* red = (LAS float*)(lds + 24576);
    float* MOD = (float*)(p.ws + OFF_MOD);
    const int tid = otid();
    if ((int)blockIdx.x >= 192) return;
    for (int i = tid; i < 3 * 2048; i += 512) { const int r = i >> 11, k = i & 2047; const float v = (r < 2) ? p.c[r * 2048 + k] : p.c_ctx[k]; sl[i] = v * sigm(v); }
    __syncthreads();
    for (int item = blockIdx.x; item < 192; item += gridDim.x) {
        const int l = item / 96, cb = item % 96, cg4 = tid & 31, ksl = tid >> 5;
        const float* W = p.ada_w + ((size_t)l * 2048 + ksl * 128) * 12288 + cb * 128 + cg4 * 4;
        f32x4 a0 = {0.f, 0.f, 0.f, 0.f}, a1 = a0, a2 = a0;
#pragma unroll 8
        for (int k = 0; k < 128; ++k) { const f32x4 w = *(const f32x4*)(W + (size_t)k * 12288);
            a0 += sl[ksl * 128 + k] * w; a1 += sl[2048 + ksl * 128 + k] * w; a2 += sl[4096 + ksl * 128 + k] * w; }
        *(LAS f32x4*)(red + (ksl * 3 + 0) * 128 + cg4 * 4) = a0; *(LAS f32x4*)(red + (ksl * 3 + 1) * 128 + cg4 * 4) = a1; *(LAS f32x4*)(red + (ksl * 3 + 2) * 128 + cg4 * 4) = a2;
        __syncthreads();
        if (tid < 384) { const int r = tid >> 7, cc = tid & 127; float s = 0.f;
#pragma unroll
            for (int ks = 0; ks < 16; ++ks) s += red[(ks * 3 + r) * 128 + cc];
            MOD[(l * 3 + r) * 12288 + cb * 128 + cc] = s + p.ada_b[l * 12288 + cb * 128 + cc]; }
        __syncthreads();
    }
}

__device__ void phase_convert(const Params& p, int l, LAS unsigned char* lds, int t0, int t1, int w, int nw) {
    LAS float* tile = (LAS float*)lds;
    const int tid = otid();
    for (int T = t0 + w; T < t1; T += nw) {
        const float* src; bf16_t* dst; int K, Nsrc, t = T;
        if (t < 3328) { src = p.w_in + (size_t)l * 2048 * INC; K = 2048; Nsrc = INC; dst = (bf16_t*)(p.ws + OFF_WIN); }
        else if ((t -= 3328) < 4096) { const int i = t >> 10; t &= 1023; src = p.gate_w + (size_t)(l * 4 + i) * 2048 * 2048; K = 2048; Nsrc = 2048; dst = (bf16_t*)(p.ws + OFF_WGT) + (size_t)i * 2048 * 2048; }
        else if ((t -= 4096) < 1024) { const int i = t >> 8; t &= 255; src = p.br_w + (size_t)(l * 4 + i) * 512 * 2048; K = 512; Nsrc = 2048; dst = (bf16_t*)(p.ws + OFF_WBR) + (size_t)i * 2048 * 512; }
        else if ((t -= 1024) < 1024) { src = p.out_w + (size_t)l * 2048 * 2048; K = 2048; Nsrc = 2048; dst = (bf16_t*)(p.ws + OFF_WOUT); }
        else if ((t -= 1024) < 4096) { src = p.ffn_w1 + (size_t)l * 2048 * 8192; K = 2048; Nsrc = 8192; dst = (bf16_t*)(p.ws + OFF_W1); }
        else { t -= 4096; src = p.ffn_w2 + (size_t)l * 8192 * 2048; K = 8192; Nsrc = 2048; dst = (bf16_t*)(p.ws + OFF_W2); }
        const int ntk = K >> 6, tk = t % ntk, tn = t / ntk;
#pragma unroll
        for (int i = 0; i < 8; ++i) { const int e = tid + 512 * i, kk = e >> 6, nn = e & 63, n = tn * 64 + nn;
            tile[kk * 65 + nn] = (n < Nsrc) ? src[(size_t)(tk * 64 + kk) * Nsrc + n] : 0.f; }
        __syncthreads();
        { const int nn = tid >> 3, k8 = (tid & 7) * 8; float f[8];
#pragma unroll
          for (int j = 0; j < 8; ++j) f[j] = tile[(k8 + j) * 65 + nn];
          *(u32x4*)(dst + (size_t)(tn * 64 + nn) * K + tk * 64 + k8) = pack8(f); }
        __syncthreads();
    }
}

__device__ void build_wx1(const Params& p, int l) {
    bf16_t* WX = (bf16_t*)(p.ws + OFF_WX1);
    for (int idx = blockIdx.x * 512 + otid(); idx < 2560 * 384; idx += gridDim.x * 512) {
        const int n = idx / 384, k = idx - n * 384; float v = 0.f;
        if (n < 1024) { const int z = n >> 9, c = n & 511, kk = k - z * 64; if (kk >= 0 && kk < 64) v = p.rw_w_up[((size_t)(l * 2 + z) * 64 + kk) * 512 + c]; }
        else if (n < 2048) { const int z = (n - 1024) >> 9, c = n & 511, kk = k - 128 - z * 64; if (kk >= 0 && kk < 64) v = p.rw_a_up[((size_t)(l * 2 + z) * 64 + kk) * 512 + c]; }
        else { const int c = n - 2048, kk = k - 256; if (kk >= 0) v = p.rw_g_up[((size_t)l * 128 + kk) * 512 + c]; }
        WX[idx] = f2bf(v);
    }
}

__device__ void build_wx2(const Params& p, int l) {
    bf16_t* WX = (bf16_t*)(p.ws + OFF_WX2);
    for (int idx = blockIdx.x * 512 + otid(); idx < 2048 * 512; idx += gridDim.x * 512) {
        const int n = idx >> 9, k = idx & 511, gz = n >> 9, z = gz & 1, ch = n & 511, nb = ch >> 6, j = ch & 63, kk = k - nb * 64; float v = 0.f;
        if (kk >= 0 && kk < 64) { const size_t wi = (((size_t)(l * 2 + z) * 8 + nb) * 64 + kk) * 64 + j; v = (gz >> 1) ? p.lru_w_x[wi] : p.lru_w_a[wi]; }
        WX[idx] = f2bf(v);
    }
}
__device__ void build_xc(const Params& p, int l) {
    const bf16_t* U = (const bf16_t*)(p.ws + OFF_U); bf16_t* XC = (bf16_t*)(p.ws + OFF_XC);
    for (int idx = blockIdx.x * 512 + otid(); idx < MT * 64; idx += gridDim.x * 512) {
        const int m = idx >> 6, c8 = (idx & 63) * 8;
        const bool isctx = m >= ML; int b, L, pcur;
        if (!isctx) { b = m >> 13; const int t = m & 8191; pcur = (t & 63) * 128 + (t >> 6); L = SEQ; } else { const int mm = m - ML; b = mm >> 8; pcur = mm & 255; L = CTX; }
        float acc[8];
        { const f32x4 c0 = *(const f32x4*)(p.lru_conv_b + l * 512 + c8), c1 = *(const f32x4*)(p.lru_conv_b + l * 512 + c8 + 4);
          acc[0] = c0.x; acc[1] = c0.y; acc[2] = c0.z; acc[3] = c0.w; acc[4] = c1.x; acc[5] = c1.y; acc[6] = c1.z; acc[7] = c1.w; }
#pragma unroll
        for (int jt = 0; jt < 4; ++jt) { const int pp = pcur + jt - 2;
            if (pp >= 0 && pp < L) { const int row = isctx ? (ML + b * CTX + pp) : (b * SEQ + ((pp & 127) * 64 + (pp >> 7)));
                float x[8]; unpack8(*(const u32x4*)(U + (size_t)row * INP + C_LRU_X + c8), x);
                const f32x4 w0 = *(const f32x4*)(p.lru_conv_w + (l * 4 + jt) * 512 + c8), w1 = *(const f32x4*)(p.lru_conv_w + (l * 4 + jt) * 512 + c8 + 4);
                acc[0] += w0.x * x[0]; acc[1] += w0.y * x[1]; acc[2] += w0.z * x[2]; acc[3] += w0.w * x[3]; acc[4] += w1.x * x[4]; acc[5] += w1.y * x[5]; acc[6] += w1.z * x[6]; acc[7] += w1.w * x[7]; } }
        *(u32x4*)(XC + (size_t)m * 512 + c8) = pack8(acc);
    }
}
__device__ void build_kk_la(const Params& p, int l) {
    const bf16_t* U = (const bf16_t*)(p.ws + OFF_U); bf16_t* NKK = (bf16_t*)(p.ws + OFF_NKK); bf16_t* LA = (bf16_t*)(p.ws + OFF_LA);
    for (int idx = blockIdx.x * 512 + otid(); idx < MT * 64; idx += gridDim.x * 512) {
        const int m = idx >> 6, q = idx & 63, c8 = q * 8;
        { float k[8]; unpack8(*(const u32x4*)(U + (size_t)m * INP + C_RW_K + c8), k);
          const f32x4 w0 = *(const f32x4*)(p.rw_k_k + l * 512 + c8), w1 = *(const f32x4*)(p.rw_k_k + l * 512 + c8 + 4);
          k[0] *= w0.x; k[1] *= w0.y; k[2] *= w0.z; k[3] *= w0.w; k[4] *= w1.x; k[5] *= w1.y; k[6] *= w1.z; k[7] *= w1.w;
          float ss = 0.f;
#pragma unroll
          for (int j = 0; j < 8; ++j) ss += k[j] * k[j];
          ss = red8(ss);
          const float inv = -1.0f / fmaxf(sqrtf(ss), 1e-12f);
#pragma unroll
          for (int j = 0; j < 8; ++j) k[j] *= inv;
          *(u32x4*)(NKK + (size_t)m * 512 + c8) = pack8(k); }
        { const int z = q >> 5, g8 = (q & 31) * 8;
          float wd[16]; { float t0[8], t1[8]; unpack8(*(const u32x4*)(U + (size_t)m * INP + C_GLA_W + z * 16), t0); unpack8(*(const u32x4*)(U + (size_t)m * INP + C_GLA_W + z * 16 + 8), t1);
#pragma unroll
            for (int j = 0; j < 8; ++j) { wd[j] = t0[j]; wd[8 + j] = t1[j]; } }
          float d[8];
          { const f32x4 b0 = *(const f32x4*)(p.gla_w0 + (l * 2 + z) * 256 + g8), b1 = *(const f32x4*)(p.gla_w0 + (l * 2 + z) * 256 + g8 + 4);
            d[0] = b0.x; d[1] = b0.y; d[2] = b0.z; d[3] = b0.w; d[4] = b1.x; d[5] = b1.y; d[6] = b1.z; d[7] = b1.w; }
#pragma unroll
          for (int r = 0; r < 16; ++r) { const float* wp = p.gla_w_up + ((size_t)(l * 2 + z) * 16 + r) * 256 + g8; const f32x4 u0 = *(const f32x4*)wp, u1 = *(const f32x4*)(wp + 4);
              d[0] += wd[r] * u0.x; d[1] += wd[r] * u0.y; d[2] += wd[r] * u0.z; d[3] += wd[r] * u0.w; d[4] += wd[r] * u1.x; d[5] += wd[r] * u1.y; d[6] += wd[r] * u1.z; d[7] += wd[r] * u1.w; }
#pragma unroll
          for (int j = 0; j < 8; ++j) d[j] = log_sigm(d[j]) * (1.0f / 16.0f);
          *(u32x4*)(LA + ((size_t)z * MT + m) * 256 + g8) = pack8(d); }
    }
}
__device__ void build_ax1(const Params& p) {
    const bf16_t* U = (const bf16_t*)(p.ws + OFF_U); bf16_t* AX = (bf16_t*)(p.ws + OFF_AX1);
    for (int idx = blockIdx.x * 512 + otid(); idx < MT * 48; idx += gridDim.x * 512) {
        const int m = idx / 48, q = idx - m * 48;
        float f[8]; unpack8(*(const u32x4*)(U + (size_t)m * INP + C_RW_W + q * 8), f);
        if (q < 16) {
#pragma unroll
            for (int j = 0; j < 8; ++j) f[j] = tanh_(f[j]); }
        else if (q >= 32) {
#pragma unroll
            for (int j = 0; j < 8; ++j) f[j] = sigm(f[j]); }
        *(u32x4*)(AX + (size_t)m * 384 + q * 8) = pack8(f);
    }
}

__device__ void phase_norm(const float* srcL, const float* srcC, const float* nw, const float* modl, int shoff, int scoff, bf16_t* dst, int M,
                           const float* part = nullptr, int nsplit = 0, const float* pgate = nullptr, float* wb = nullptr) {
    const int tid = otid(), wid = tid >> 6, lane = tid & 63;
    for (int m = blockIdx.x * 8 + wid; m < M; m += gridDim.x * 8) {
        const float* xr = (m < ML) ? srcL + (size_t)m * 2048 : srcC + (size_t)(m - ML) * 2048;
        const float* mr = modl + ((m < ML) ? (m >> 13) : 2) * 12288;
        f32x4 v[8]; float ss = 0.f;
#pragma unroll
        for (int j = 0; j < 8; ++j) v[j] = *(const f32x4*)(xr + j * 256 + lane * 4);
        if (nsplit > 0 && m >= ML) {
#pragma unroll
            for (int j = 0; j < 8; ++j) { const int col = j * 256 + lane * 4; f32x4 a = {0.f, 0.f, 0.f, 0.f};
                for (int sidx = 0; sidx < nsplit; ++sidx) a += *(const f32x4*)(part + ((size_t)sidx * MC + (m - ML)) * 2048 + col);
                v[j] += *(const f32x4*)(pgate + col) * a;
                if (wb) *(f32x4*)(wb + (size_t)m * 2048 + col) = v[j]; }
        }
#pragma unroll
        for (int j = 0; j < 8; ++j) ss += v[j].x * v[j].x + v[j].y * v[j].y + v[j].z * v[j].z + v[j].w * v[j].w;
        ss = wave_sum(ss);
        const float rs = rsqrtf(ss * (1.0f / 2048.0f) + EPS);
#pragma unroll
        for (int j = 0; j < 8; ++j) { const int col = j * 256 + lane * 4;
            const f32x4 w = *(const f32x4*)(nw + col), sh = *(const f32x4*)(mr + shoff + col), sc = *(const f32x4*)(mr + scoff + col);
            const f32x4 y = (v[j] * rs * w) * (1.0f + sc) + sh;
            u32x2 o; o.x = cvt_pk_bf16(y.x, y.y); o.y = cvt_pk_bf16(y.z, y.w);
            *(u32x2*)(dst + (size_t)m * 2048 + col) = o; }
    }
}
__device__ void phase_final_norm(const float* src, const float* nw, float* out) {
    const int tid = otid(), wid = tid >> 6, lane = tid & 63;
    for (int m = blockIdx.x * 8 + wid; m < ML; m += gridDim.x * 8) {
        const float* xr = src + (size_t)m * 2048;
        f32x4 v[8]; float ss = 0.f;
#pragma unroll
        for (int j = 0; j < 8; ++j) { v[j] = *(const f32x4*)(xr + j * 256 + lane * 4); ss += v[j].x * v[j].x + v[j].y * v[j].y + v[j].z * v[j].z + v[j].w * v[j].w; }
        ss = wave_sum(ss);
        const float rs = rsqrtf(ss * (1.0f / 2048.0f) + EPS);
#pragma unroll
        for (int j = 0; j < 8; ++j) { const int col = j * 256 + lane * 4; const f32x4 w = *(const f32x4*)(nw + col);
            *(f32x4*)(out + (size_t)m * 2048 + col) = v[j] * rs * w; }
    }
}

constexpr int TOKT = 66;
__device__ __forceinline__ void phase_prep(const Params& p, int l, LAS unsigned char* lds, int parts) {
    const int tid = otid(), lane = tid & 63;
    const bf16_t* U = (const bf16_t*)(p.ws + OFF_U);
    bf16_t* LW = (bf16_t*)(p.ws + OFF_LW); bf16_t* AA = (bf16_t*)(p.ws + OFF_AA); bf16_t* NKK = (bf16_t*)(p.ws + OFF_NKK); bf16_t* LA = (bf16_t*)(p.ws + OFF_LA);
    if (parts & 1) {
        LAS float* tw = (LAS float*)lds;
        LAS float* ad = (LAS float*)(lds + TOKT * 128 * 4);
        LAS float* gw = (LAS float*)(lds + 2 * TOKT * 128 * 4);
        for (int tile = blockIdx.x; tile < MT / TOKT; tile += gridDim.x) {
            const int m0 = tile * TOKT;
            { const int tid = otid();
            for (int e = tid; e < TOKT * 32; e += 512) { const int tok = e >> 5, jj = e & 31; gw[e] = bf2f(U[(size_t)(m0 + tok) * INP + C_GLA_W + jj]); } }
            __syncthreads();
            { const int c = otid(); const float kkw = p.rw_k_k[l * 512 + c];
              _Pragma("unroll 1") for (int tok = 0; tok < TOKT; ++tok) { const float val = bf2f(U[(size_t)(m0 + tok) * INP + C_RW_K + c]) * kkw;
                  const float ss = wave_sum(val * val); NKK[(size_t)(m0 + tok) * 512 + c] = f2bf(-val / fmaxf(sqrtf(ss), 1e-12f)); } }
            { const int tid = otid(); const int z = tid >> 8, cc = tid & 255; float gcol[16];
              const float* gwb = p.gla_w_up + (size_t)l * 2 * 16 * 256; asm volatile("" : "+s"(gwb));
#pragma unroll
              for (int j = 0; j < 16; ++j) gcol[j] = gwb[(unsigned)((z * 16 + j) * 256 + cc)];
              const float w0 = p.gla_w0[(l * 2 + z) * 256 + cc];
              _Pragma("unroll 1") for (int tok = 0; tok < TOKT; ++tok) { float d = w0;
#pragma unroll
                  for (int j = 0; j < 16; ++j) d += gw[tok * 32 + z * 16 + j] * gcol[j];
                  LA[((size_t)z * MT + m0 + tok) * 256 + cc] = f2bf(log_sigm(d) * (1.0f / 16.0f)); } }
            __syncthreads();
        }
    }
    if (parts & 2) {
        const bf16_t* GATES = (const bf16_t*)(p.ws + OFF_GATES); const bf16_t* XC = (const bf16_t*)(p.ws + OFF_XC);
        bf16_t* LACUM = (bf16_t*)(p.ws + OFF_LACUM); bf16_t* LHLOC = (bf16_t*)(p.ws + OFF_LHLOC);
        float* APROD = (float*)(p.ws + OFF_APROD); float* HEND = (float*)(p.ws + OFF_HEND);
        for (int item = blockIdx.x; item < 2 * 2 * NCH; item += gridDim.x) {
            const int ch = otid();
            const int z = item / (2 * NCH), b = (item / NCH) & 1, cidx = item % NCH;
            const bool isctx = cidx < 8; const int p0 = (isctx ? cidx : cidx - 8) * 32;
            auto rowof = [&](int pp) -> int { return isctx ? (ML + b * CTX + pp) : (b * SEQ + ((pp & 127) * 64 + (pp >> 7))); };
            const float sp = softplus_(-p.lru_lambda[(l * 2 + z) * 512 + ch]);
            float h = 0.f, Ac = 1.f;
#pragma unroll 1
            for (int half = 0; half < 2; ++half) {
                bf16_t rgv[16], igv[16], xcv[16]; int rows[16];
#pragma unroll
                for (int i = 0; i < 16; ++i) { const int ii = half * 16 + i, pp = z ? 31 - ii : ii; const int m = rowof(p0 + pp); rows[i] = m;
                    rgv[i] = GATES[((size_t)z * MT + m) * 512 + ch]; igv[i] = GATES[((size_t)(2 + z) * MT + m) * 512 + ch]; xcv[i] = XC[(size_t)m * 512 + ch]; }
#pragma unroll
                for (int i = 0; i < 16; ++i) { const float log_a = -8.0f * bf2f(rgv[i]) * sp, a = __expf(log_a);
                    const float bt = sqrtf(-expm1f(2.0f * log_a)) * bf2f(igv[i]) * bf2f(xcv[i]);
                    h = a * h + bt; Ac *= a;
                    const size_t o = ((size_t)z * MT + rows[i]) * 512 + ch;
                    LACUM[o] = f2bf(Ac); LHLOC[o] = f2bf(h); }
            }
            const size_t so = ((size_t)(z * 2 + b) * NCH + cidx) * 512 + ch;
            APROD[so] = Ac; HEND[so] = h;
        }
    }
}

template <int MIX> struct ScanCfg;
template <> struct ScanCfg<0> { static constexpr int STEPF = 352, EPL = 8, NRAW = 22; };
template <> struct ScanCfg<1> { static constexpr int STEPF = 224, EPL = 8, NRAW = 14; };
template <> struct ScanCfg<2> { static constexpr int STEPF = 292, EPL = 16, NRAW = 19; };
template <> struct ScanCfg<3> { static constexpr int STEPF = 292, EPL = 16, NRAW = 19; };

template <int MIX>
__device__ void scan_role(const Params& p, const int l, LAS unsigned char* lds, const int chain, const int sub) {
    constexpr int STEPF = ScanCfg<(MIX)>::STEPF, EPL = ScanCfg<(MIX)>::EPL, NRAW = ScanCfg<(MIX)>::NRAW, BUFB = 45056;
    const int tid = otid(), wid = tid >> 6, lane = tid & 63, rs = lane >> 4, ks = lane & 15, row = wid * 4 + rs;
    const bf16_t* U = (const bf16_t*)(p.ws + OFF_U);
    const bf16_t* LW = (const bf16_t*)(p.ws + OFF_LW); const bf16_t* AA = (const bf16_t*)(p.ws + OFF_AA); const bf16_t* NKK = (const bf16_t*)(p.ws + OFF_NKK); const bf16_t* LA = (const bf16_t*)(p.ws + OFF_LA);
    int z, b, h;
    if (MIX == 0) { z = chain >> 4; b = (chain >> 3) & 1; h = chain & 7; } else { z = chain >> 3; b = (chain >> 2) & 1; h = chain & 3; }
    LAS float* ylds = (LAS float*)(lds + 2 * BUFB);
    auto tokrow = [&](int sg) -> int { if (sg < CTX) { const int t = z ? (CTX - 1 - sg) : sg; return ML + b * CTX + t; } const int s2 = sg - CTX; const int t = z ? (SEQ - 1 - s2) : s2; return b * SEQ + t; };
    float fb = 0.f, ib = 0.f;
    if (MIX >= 2) { fb = p.ml_f_b[(l * 2 + z) * 4 + h]; ib = p.ml_i_b[(l * 2 + z) * 4 + h]; }
    const int stid = tid & 255, sq = stid & 15;
    f32x4 ka4 = {0.f, 0.f, 0.f, 0.f};
    if (MIX == 0) ka4 = *(const f32x4*)(p.rw_k_a + l * 512 + h * 64 + sq * 4);
    struct Raw { u32x4 q0, q1; u32x2 d0, d1, d2, d3, d4; unsigned v; };
    Raw rwA, rwB; bf16_t rsc = 0;
    rwA.q0 = (u32x4){0u, 0u, 0u, 0u}; rwA.q1 = rwA.q0; rwA.d0 = (u32x2){0u, 0u}; rwA.d1 = rwA.d0; rwA.d2 = rwA.d0; rwA.d3 = rwA.d0; rwA.d4 = rwA.d0; rwA.v = 0u; rwB = rwA;
    auto load_raw1 = [&](int blk, int i, Raw& r) {
        const int sst = (stid >> 4) + 16 * i;
        const size_t m = (size_t)tokrow(blk * 32 + sst);
        if (MIX == 0) { const int cc = h * 64 + sq * 4;
            r.d0 = *(const u32x2*)(LW + ((size_t)z * MT + m) * 512 + cc); r.d1 = *(const u32x2*)(NKK + m * 512 + cc); r.d2 = *(const u32x2*)(AA + ((size_t)z * MT + m) * 512 + cc);
            r.d3 = *(const u32x2*)(U + m * INP + C_RW_K + cc); r.d4 = *(const u32x2*)(U + m * INP + C_RW_R + cc);
            r.v = *(const unsigned*)(U + m * INP + C_RW_V + h * 64 + sub * 32 + sq * 2);
        } else if (MIX == 1) { const int cc = h * 64 + sq * 4;
            r.d0 = *(const u32x2*)(LA + ((size_t)z * MT + m) * 256 + cc); r.d1 = *(const u32x2*)(U + m * INP + C_GLA_K + cc); r.d2 = *(const u32x2*)(U + m * INP + C_GLA_Q + cc);
            r.v = *(const unsigned*)(U + m * INP + C_GLA_V + h * 128 + sub * 32 + sq * 2);
        } else { const int cc = h * 128 + sq * 8;
            r.q0 = *(const u32x4*)(U + m * INP + C_ML_K + cc); r.q1 = *(const u32x4*)(U + m * INP + C_ML_Q + cc);
            r.v = *(const unsigned*)(U + m * INP + C_ML_V + h * 128 + sub * 32 + sq * 2);
        }
    };
    auto load_raw = [&](int blk) {
        load_raw1(blk, 0, rwA); load_raw1(blk, 1, rwB);
        if (MIX >= 2 && stid < 64) { const int st = stid & 31, which = (stid >> 5) & 1; const size_t m2 = (size_t)tokrow(blk * 32 + st); rsc = U[m2 * INP + (which ? C_ML_I : C_ML_F) + z * 4 + h]; }
    };
    auto store_img1 = [&](int bufsel, int i, const Raw& r) {
        const int sst = (stid >> 4) + 16 * i;
        LAS float* sp = (LAS float*)(lds + bufsel * BUFB) + sst * STEPF;
        const f32x2 vv = {__uint_as_float(r.v << 16), __uint_as_float(r.v & 0xffff0000u)};
        if (MIX == 0) {
            float lw[4], nk[4], a[4], k[4], rr[4]; unpack4(r.d0, lw); unpack4(r.d1, nk); unpack4(r.d2, a); unpack4(r.d3, k); unpack4(r.d4, rr);
            *(LAS f32x4*)(sp + sq * 4) = (f32x4){__expf(lw[0]), __expf(lw[1]), __expf(lw[2]), __expf(lw[3])};
            *(LAS f32x4*)(sp + 64 + sq * 4) = (f32x4){nk[0], nk[1], nk[2], nk[3]};
            *(LAS f32x4*)(sp + 128 + sq * 4) = (f32x4){-nk[0] * a[0], -nk[1] * a[1], -nk[2] * a[2], -nk[3] * a[3]};
            *(LAS f32x4*)(sp + 192 + sq * 4) = (f32x4){k[0] * (1.0f + (a[0] - 1.0f) * ka4.x), k[1] * (1.0f + (a[1] - 1.0f) * ka4.y), k[2] * (1.0f + (a[2] - 1.0f) * ka4.z), k[3] * (1.0f + (a[3] - 1.0f) * ka4.w)};
            *(LAS f32x4*)(sp + 256 + sq * 4) = (f32x4){rr[0], rr[1], rr[2], rr[3]};
            *(LAS f32x2*)(sp + 320 + sq * 2) = vv;
        } else if (MIX == 1) {
            float la[4], k[4], q[4]; unpack4(r.d0, la); unpack4(r.d1, k); unpack4(r.d2, q);
            *(LAS f32x4*)(sp + sq * 4) = (f32x4){__expf(la[0]), __expf(la[1]), __expf(la[2]), __expf(la[3])};
            *(LAS f32x4*)(sp + 64 + sq * 4) = (f32x4){k[0], k[1], k[2], k[3]};
            *(LAS f32x4*)(sp + 128 + sq * 4) = (f32x4){q[0] * 0.125f, q[1] * 0.125f, q[2] * 0.125f, q[3] * 0.125f};
            *(LAS f32x2*)(sp + 192 + sq * 2) = vv;
        } else {
            float k[8], q[8]; unpack8(r.q0, k); unpack8(r.q1, q);
            const float ksc = 0.08838834764831845f;
            *(LAS f32x4*)(sp + sq * 8) = (f32x4){k[0] * ksc, k[1] * ksc, k[2] * ksc, k[3] * ksc}; *(LAS f32x4*)(sp + sq * 8 + 4) = (f32x4){k[4] * ksc, k[5] * ksc, k[6] * ksc, k[7] * ksc};
            *(LAS f32x4*)(sp + 128 + sq * 8) = (f32x4){q[0], q[1], q[2], q[3]}; *(LAS f32x4*)(sp + 128 + sq * 8 + 4) = (f32x4){q[4], q[5], q[6], q[7]};
            *(LAS f32x2*)(sp + 256 + sq * 2) = (MIX == 3) ? (f32x2){1.0f, 1.0f} : vv;
        }
    };
    auto store_img = [&](int bufsel) {
        store_img1(bufsel, 0, rwA); store_img1(bufsel, 1, rwB);
        if (MIX >= 2 && stid < 64) { const int st = stid & 31, which = stid >> 5; const float xv = bf2f(rsc); LAS float* img = (LAS float*)(lds + bufsel * BUFB);
            if (which == 0) img[st * STEPF + 288] = sigm(xv + fb); else img[st * STEPF + 289] = __expf(xv + ib); }
    };
    f32x2 S2[EPL / 2];
#pragma unroll
    for (int j = 0; j < EPL / 2; ++j) S2[j] = (f32x2){0.f, 0.f};
    bf16_t* Yout = (bf16_t*)(p.ws + (MIX == 0 ? OFF_YRW : (MIX == 1 ? OFF_YGL : OFF_YML)));
    const int cbase = (MIX == 0) ? (h * 64 + sub * 32) : (h * 128 + sub * 32);
    constexpr int NV = EPL / 4;
    const int crs = lane >> 3, cks = lane & 7, crow = wid * 8 + crs;
    struct In { f32x4 a[NV], b[NV], c[NV], d[NV], e[NV]; float v, f, iw; };
    auto load_in = [&](const LAS float* sp) -> In {
        In r;
#pragma unroll
        for (int j = 0; j < NV; ++j) { const int o = (j * 8 + cks) * 4;
            if (MIX == 0) { r.a[j] = *(const LAS f32x4*)(sp + o); r.b[j] = *(const LAS f32x4*)(sp + 64 + o); r.c[j] = *(const LAS f32x4*)(sp + 128 + o); r.d[j] = *(const LAS f32x4*)(sp + 192 + o); r.e[j] = *(const LAS f32x4*)(sp + 256 + o); }
            else if (MIX == 1) { r.a[j] = *(const LAS f32x4*)(sp + o); r.b[j] = *(const LAS f32x4*)(sp + 64 + o); r.c[j] = *(const LAS f32x4*)(sp + 128 + o); r.d[j] = r.a[j]; r.e[j] = r.a[j]; }
            else { r.a[j] = *(const LAS f32x4*)(sp + o); r.c[j] = *(const LAS f32x4*)(sp + 128 + o); r.b[j] = r.a[j]; r.d[j] = r.a[j]; r.e[j] = r.a[j]; } }
        if (MIX == 0) { r.v = sp[320 + crow]; r.f = 0.f; r.iw = 0.f; }
        else if (MIX == 1) { r.v = sp[192 + crow]; r.f = 0.f; r.iw = 0.f; }
        else { r.v = sp[256 + crow]; const f32x2 fi = *(const LAS f32x2*)(sp + 288); r.f = fi.x; r.iw = fi.y; }
        return r;
    };
#define LO2(V_) ((f32x2){(V_)[0], (V_)[1]})
#define HI2(V_) ((f32x2){(V_)[2], (V_)[3]})

    float* DENp = (float*)(p.ws + OFF_DEN);
    auto write_out = [&](int blk) {
        const LAS float* yl = ylds + (blk & 1) * 1024;
        if (MIX < 3) {
#pragma unroll
            for (int i = 0; i < 2; ++i) { const int st = (stid >> 4) + 16 * i, rp = stid & 15; const size_t m = (size_t)tokrow(blk * 32 + st);
                *(unsigned*)(Yout + ((size_t)z * MT + m) * 512 + cbase + 2 * rp) = cvt_pk_bf16(yl[st * 32 + 2 * rp], yl[st * 32 + 2 * rp + 1]); }
        } else if (stid < 32) { const size_t m = (size_t)tokrow(blk * 32 + stid); DENp[((size_t)z * MT + m) * 4 + h] = yl[stid * 32]; }
    };
    if (wid >= 4) { load_raw(0); store_img(0); load_raw(1); }
    __syncthreads();
    for (int blk = 0; blk < NCH; ++blk) {
        if (wid >= 4) {
            if (blk + 1 < NCH) store_img((blk + 1) & 1);
            if (blk >= 1) write_out(blk - 1);
            if (blk + 2 < NCH) load_raw(blk + 2);
        } else {
        LAS float* ylw = ylds + (blk & 1) * 1024;
        const LAS float* img = (const LAS float*)(lds + (blk & 1) * BUFB);
        In cur = load_in(img);
#pragma unroll 1
        for (int g = 0; g < 4; ++g) {
        float pd[8];
#pragma unroll
        for (int s8 = 0; s8 < 8; ++s8) {
            const int st = g * 8 + s8;
            const In nxt = load_in(img + ((st + 1 < 32) ? (st + 1) : 31) * STEPF);
            if (MIX == 0) {
                f32x2 da = S2[0] * LO2(cur.b[0]), db = S2[1] * HI2(cur.b[0]);
                f32x2 t[EPL / 2];
#pragma unroll
                for (int j = 1; j < NV; ++j) { da += S2[2 * j] * LO2(cur.b[j]); db += S2[2 * j + 1] * HI2(cur.b[j]); }
                const f32x2 d0 = da + db;
                float sa = d0.x + d0.y;
#pragma unroll
                for (int j = 0; j < NV; ++j) { t[2 * j] = S2[2 * j] * LO2(cur.a[j]) + LO2(cur.d[j]) * cur.v; t[2 * j + 1] = S2[2 * j + 1] * HI2(cur.a[j]) + HI2(cur.d[j]) * cur.v; }
                sa = red8(sa);
#pragma unroll
                for (int j = 0; j < NV; ++j) { S2[2 * j] = t[2 * j] + LO2(cur.c[j]) * sa; S2[2 * j + 1] = t[2 * j + 1] + HI2(cur.c[j]) * sa; }
                f32x2 ea = S2[0] * LO2(cur.e[0]), eb = S2[1] * HI2(cur.e[0]);
#pragma unroll
                for (int j = 1; j < NV; ++j) { ea += S2[2 * j] * LO2(cur.e[j]); eb += S2[2 * j + 1] * HI2(cur.e[j]); }
                const f32x2 d1 = ea + eb;
                pd[s8] = d1.x + d1.y;
            } else if (MIX == 1) {
#pragma unroll
                for (int j = 0; j < NV; ++j) { S2[2 * j] = S2[2 * j] * LO2(cur.a[j]) + LO2(cur.b[j]) * cur.v; S2[2 * j + 1] = S2[2 * j + 1] * HI2(cur.a[j]) + HI2(cur.b[j]) * cur.v; }
                f32x2 ea = S2[0] * LO2(cur.c[0]), eb = S2[1] * HI2(cur.c[0]);
#pragma unroll
                for (int j = 1; j < NV; ++j) { ea += S2[2 * j] * LO2(cur.c[j]); eb += S2[2 * j + 1] * HI2(cur.c[j]); }
                const f32x2 d1 = ea + eb;
                pd[s8] = d1.x + d1.y;
            } else {
                const float iv = cur.iw * cur.v, f = cur.f;
#pragma unroll
                for (int j = 0; j < NV; ++j) { S2[2 * j] = S2[2 * j] * f + LO2(cur.a[j]) * iv; S2[2 * j + 1] = S2[2 * j + 1] * f + HI2(cur.a[j]) * iv; }
                f32x2 ea = S2[0] * LO2(cur.c[0]), eb = S2[1] * HI2(cur.c[0]);
#pragma unroll
                for (int j = 1; j < NV; ++j) { ea += S2[2 * j] * LO2(cur.c[j]); eb += S2[2 * j + 1] * HI2(cur.c[j]); }
                const f32x2 d1 = ea + eb;
                pd[s8] = d1.x + d1.y;
            }
            cur = nxt;
        }
#pragma unroll
        for (int s8 = 0; s8 < 8; ++s8) pd[s8] += dppmov<0xB1>(pd[s8]);
#pragma unroll
        for (int s8 = 0; s8 < 8; ++s8) pd[s8] += dppmov<0x4E>(pd[s8]);
#pragma unroll
        for (int s8 = 0; s8 < 8; ++s8) pd[s8] += dppmov<0x141>(pd[s8]);
        float yk = pd[0];
#pragma unroll
        for (int s8 = 1; s8 < 8; ++s8) yk = (cks == s8) ? pd[s8] : yk;
        ylw[(g * 8 + cks) * 32 + crow] = yk;
        }
        }
        __syncthreads();
    }
    if (wid >= 4) write_out(NCH - 1);
}

__device__ void lru_carry_role(const Params& p, int zb) {
    const float* APROD = (const float*)(p.ws + OFF_APROD); const float* HEND = (const float*)(p.ws + OFF_HEND); float* CARRY = (float*)(p.ws + OFF_CARRY);
    const int z = zb >> 1, ch = otid(); const size_t base = (size_t)zb * NCH * 512 + ch;
    float h = 0.f;
    for (int g8 = 0; g8 < NCH / 8; ++g8) {
        float a[8], e[8]; int ci[8];
#pragma unroll
        for (int j = 0; j < 8; ++j) { const int i = g8 * 8 + j; ci[j] = (i < 8) ? (z ? 7 - i : i) : (z ? (NCH - 1) - (i - 8) : i); a[j] = APROD[base + (size_t)ci[j] * 512]; e[j] = HEND[base + (size_t)ci[j] * 512]; }
#pragma unroll
        for (int j = 0; j < 8; ++j) { CARRY[base + (size_t)ci[j] * 512] = h; h = a[j] * h + e[j]; }
    }
}

__device__ void phase_scan(const Params& p, int l, LAS unsigned char* lds, int cmask = 31) {
    if (cmask == 31) {
        const int nidle = (int)gridDim.x - 212;
        const int w = nidle > 0 ? (int)blockIdx.x - 212 : (int)blockIdx.x, nw = nidle > 0 ? nidle : (int)gridDim.x;
        if (w >= 0) { phase_convert(p, l, lds, 3328, 17664, w, nw); if (l == 0) phase_convert(p, 1, lds, 0, 3328, w, nw); __syncthreads(); }
    }
    for (int role = blockIdx.x; role < 212; role += gridDim.x) {
        const int cls = role < 64 ? 1 : (role < 128 ? 2 : (role < 192 ? 4 : (role < 208 ? 8 : 16)));
        if (!(cmask & cls)) continue;
        if (role < 64) scan_role<0>(p, l, lds, role >> 1, role & 1);
        else if (role < 128) scan_role<1>(p, l, lds, (role - 64) >> 2, (role - 64) & 3);
        else if (role < 192) scan_role<2>(p, l, lds, (role - 128) >> 2, (role - 128) & 3);
        else if (role < 208) scan_role<3>(p, l, lds, role - 192, 0);
        else lru_carry_role(p, role - 208);
        __syncthreads();
    }
}

__device__ void phase_post(const Params& p, int l, LAS unsigned char* lds) {
    const int tid = otid(), wid = tid >> 6, lane = tid & 63;
    const bf16_t* U = (const bf16_t*)(p.ws + OFF_U);
    const bf16_t* YRW = (const bf16_t*)(p.ws + OFF_YRW); const bf16_t* YGL = (const bf16_t*)(p.ws + OFF_YGL); const bf16_t* YML = (const bf16_t*)(p.ws + OFF_YML);
    const float* DEN = (const float*)(p.ws + OFF_DEN);
    const bf16_t* LACUM = (const bf16_t*)(p.ws + OFF_LACUM); const bf16_t* LHLOC = (const bf16_t*)(p.ws + OFF_LHLOC); const float* CARRY = (const float*)(p.ws + OFF_CARRY);
    bf16_t* YS = (bf16_t*)(p.ws + OFF_YS); const bf16_t* GV = (const bf16_t*)(p.ws + OFF_GV);
    {
        const int c8 = lane * 8;
        float lnw8[8], rk8[8];
        { const f32x4 a0 = *(const f32x4*)(p.rw_ln_w + l * 512 + c8), a1 = *(const f32x4*)(p.rw_ln_w + l * 512 + c8 + 4), b0 = *(const f32x4*)(p.rw_r_k + l * 512 + c8), b1 = *(const f32x4*)(p.rw_r_k + l * 512 + c8 + 4);
          lnw8[0] = a0.x; lnw8[1] = a0.y; lnw8[2] = a0.z; lnw8[3] = a0.w; lnw8[4] = a1.x; lnw8[5] = a1.y; lnw8[6] = a1.z; lnw8[7] = a1.w;
          rk8[0] = b0.x; rk8[1] = b0.y; rk8[2] = b0.z; rk8[3] = b0.w; rk8[4] = b1.x; rk8[5] = b1.y; rk8[6] = b1.z; rk8[7] = b1.w; }
        _Pragma("unroll 1") for (int mi = blockIdx.x * 8 + wid; mi < MT; mi += gridDim.x * 8) { const size_t m = (size_t)mi;
            { float y0[8], y1[8], r[8], k[8], v[8], g[8], oo[8];
              unpack8(*(const u32x4*)(YRW + m * 512 + c8), y0); unpack8(*(const u32x4*)(YRW + ((size_t)MT + m) * 512 + c8), y1);
              unpack8(*(const u32x4*)(U + m * INP + C_RW_R + c8), r); unpack8(*(const u32x4*)(U + m * INP + C_RW_K + c8), k); unpack8(*(const u32x4*)(U + m * INP + C_RW_V + c8), v);
              unpack8(*(const u32x4*)(GV + m * 512 + c8), g);
              float ss = 0.f, bs = 0.f;
#pragma unroll
              for (int j = 0; j < 8; ++j) { y0[j] += y1[j]; ss += y0[j] * y0[j]; bs += r[j] * k[j] * rk8[j]; }
              ss = red8(ss); bs = red8(bs);
              const float rn = rsqrtf(ss * (1.0f / 64.0f) + EPS);
#pragma unroll
              for (int j = 0; j < 8; ++j) oo[j] = (y0[j] * rn * lnw8[j] + bs * v[j]) * g[j];
              *(u32x4*)(YS + m * 2048 + c8) = pack8(oo); }
            int b, cidx;
            if (m < (size_t)ML) { b = (int)(m >> 13); const int t = (int)(m & 8191); const int pp = (t & 63) * 128 + (t >> 6); cidx = 8 + (pp >> 5); }
            else { const int mm = (int)m - ML; b = mm >> 8; cidx = (mm & 255) >> 5; }
            float o[8];
            { float hs[8];
#pragma unroll
              for (int j = 0; j < 8; ++j) hs[j] = 0.f;
#pragma unroll
              for (int z = 0; z < 2; ++z) { float ac[8], hl[8]; unpack8(*(const u32x4*)(LACUM + ((size_t)z * MT + m) * 512 + c8), ac); unpack8(*(const u32x4*)(LHLOC + ((size_t)z * MT + m) * 512 + c8), hl);
                  const float* cp = CARRY + ((size_t)(z * 2 + b) * NCH + cidx) * 512 + c8; const f32x4 c0 = *(const f32x4*)cp, c1 = *(const f32x4*)(cp + 4);
                  hs[0] += ac[0] * c0.x + hl[0]; hs[1] += ac[1] * c0.y + hl[1]; hs[2] += ac[2] * c0.z + hl[2]; hs[3] += ac[3] * c0.w + hl[3];
                  hs[4] += ac[4] * c1.x + hl[4]; hs[5] += ac[5] * c1.y + hl[5]; hs[6] += ac[6] * c1.z + hl[6]; hs[7] += ac[7] * c1.w + hl[7]; }
              float gb[8]; unpack8(*(const u32x4*)(U + m * INP + C_LRU_G + c8), gb);
#pragma unroll
              for (int j = 0; j < 8; ++j) o[j] = hs[j] * gelu_tanh(gb[j]);
              *(u32x4*)(YS + m * 2048 + 512 + c8) = pack8(o); }
            { float a0[8], a1[8]; unpack8(*(const u32x4*)(YGL + m * 512 + c8), a0); unpack8(*(const u32x4*)(YGL + ((size_t)MT + m) * 512 + c8), a1);
              float ss = 0.f;
#pragma unroll
              for (int j = 0; j < 8; ++j) { a0[j] += a1[j]; ss += a0[j] * a0[j]; }
              ss = red16(ss);
              const float rn = rsqrtf(ss * (1.0f / 128.0f) + EPS);
              float rg[8]; unpack8(*(const u32x4*)(U + m * INP + C_GLA_R + c8), rg);
              const float* lw = p.gla_ln_w + l * 512 + c8;
#pragma unroll
              for (int j = 0; j < 8; ++j) o[j] = a0[j] * rn * lw[j] * (rg[j] * sigm(rg[j]));
              *(u32x4*)(YS + m * 2048 + 1024 + c8) = pack8(o); }
            { float a0[8], a1[8]; unpack8(*(const u32x4*)(YML + m * 512 + c8), a0); unpack8(*(const u32x4*)(YML + ((size_t)MT + m) * 512 + c8), a1);
              const int hd = lane >> 4; const float d0 = DEN[m * 4 + hd], d1 = DEN[((size_t)MT + m) * 4 + hd];
              const float i0 = 1.0f / fmaxf(fabsf(d0), 1.0f), i1 = 1.0f / fmaxf(fabsf(d1), 1.0f);
              float ss = 0.f;
#pragma unroll
              for (int j = 0; j < 8; ++j) { a0[j] = a0[j] * i0 + a1[j] * i1; ss += a0[j] * a0[j]; }
              ss = red16(ss);
              const float rn = rsqrtf(ss * (1.0f / 128.0f) + EPS);
              float og[8]; unpack8(*(const u32x4*)(U + m * INP + C_ML_O + c8), og);
              const float* lw = p.ml_ln_w + l * 512 + c8;
#pragma unroll
              for (int j = 0; j < 8; ++j) o[j] = a0[j] * rn * lw[j] * sigm(og[j]);
              *(u32x4*)(YS + m * 2048 + 1536 + c8) = pack8(o); }
        }
    }
}


#define XB_TMO      128
#define XB_XCNT(j)  (256  + 64 * (j))
#define XB_XSUB(j)  (1280 + 64 * (j))
#define XB_XGEN(j)  (2304 + 64 * (j))
#define XB_TOP      3328
#define XB_TOPGEN   3392
#define XCD_BAR_WORDS 3456
#define XB_SPIN_CAP (1u << 22)
__device__ __forceinline__ unsigned xb_ld(unsigned* p)              { return __hip_atomic_load(p, __ATOMIC_RELAXED, __HIP_MEMORY_SCOPE_AGENT); }
__device__ __forceinline__ unsigned xb_add(unsigned* p, unsigned v) { return __hip_atomic_fetch_add(p, v, __ATOMIC_RELAXED, __HIP_MEMORY_SCOPE_AGENT); }
__device__ __forceinline__ unsigned xb_xcc_id() { return (unsigned)__builtin_amdgcn_s_getreg((3 << 11) | 20) & 0xFu; }
#define XB_SPIN(cond, bar) do { unsigned _sp = 0; while (cond) { __builtin_amdgcn_s_sleep(1); \
    if ((++_sp & 255u) == 0u) { if (xb_ld(&(bar)[XB_TMO])) break; if (_sp > XB_SPIN_CAP) { atomicAdd(&(bar)[XB_TMO], 1u); break; } } } } while (0)
struct XcdBarrier { unsigned* bar; unsigned x; volatile LAS unsigned* st; };
__device__ __forceinline__ XcdBarrier xcd_barrier_post(unsigned* bar, volatile LAS unsigned* st) {
    XcdBarrier b; b.bar = bar; b.x = xb_xcc_id(); b.st = st;
    if (threadIdx.x == 0) (void)xb_add(&bar[XB_XCNT(b.x)], 1u);
    return b;
}
__device__ __forceinline__ void xcd_barrier_complete(unsigned* bar, unsigned x, unsigned& nloc, unsigned& nx) {
    const unsigned G = gridDim.x * gridDim.y * gridDim.z;
    unsigned sum, cnt, mine, sp = 0u;
    for (;;) {
        sum = 0u; cnt = 0u; mine = 0u;
#pragma unroll
        for (unsigned j = 0; j < 16; ++j) { const unsigned c = xb_ld(&bar[XB_XCNT(j)]); sum += c; cnt += (c > 0u) ? 1u : 0u; mine = (j == x) ? c : mine; }
        if (sum == G) break;
        __builtin_amdgcn_s_sleep(1);
        if ((++sp & 255u) == 0u) { if (xb_ld(&bar[XB_TMO])) break; if (sp > XB_SPIN_CAP) { atomicAdd(&bar[XB_TMO], 1u); break; } }
    }
    nloc = mine > 0u ? mine : 1u; nx = cnt > 0u ? cnt : 1u;
}
__device__ __forceinline__ void xcd_barrier(const XcdBarrier& b, unsigned* bar) {
    asm volatile("s_waitcnt vmcnt(0)" ::: "memory");
    __syncthreads();
    if (threadIdx.x == 0) {
        __builtin_amdgcn_s_waitcnt(0);
        unsigned nloc = b.st[0], nx = b.st[1];
        if (nloc == 0u) { xcd_barrier_complete(bar, b.x, nloc, nx); b.st[0] = nloc; b.st[1] = nx; }
        const unsigned old = xb_add(&bar[XB_XSUB(b.x)], 1u);
        const unsigned gen = old / nloc;
        if (old + 1u == (gen + 1u) * nloc) {
            __builtin_amdgcn_fence(__ATOMIC_RELEASE, "agent");
            asm volatile("s_waitcnt vmcnt(0)" ::: "memory");
            const unsigned og = xb_add(&bar[XB_TOP], 1u);
            const unsigned tg = og / nx;
            if (og + 1u == (tg + 1u) * nx) xb_add(&bar[XB_TOPGEN], 1u);
            else XB_SPIN(xb_ld(&bar[XB_TOPGEN]) == tg, bar);
            __builtin_amdgcn_fence(__ATOMIC_ACQUIRE, "agent");
            xb_add(&bar[XB_XGEN(b.x)], 1u);
            asm volatile("s_waitcnt vmcnt(0)" ::: "memory");
        } else {
            XB_SPIN(xb_ld(&bar[XB_XGEN(b.x)]) == gen, bar);
            __builtin_amdgcn_fence(__ATOMIC_ACQUIRE, "agent");
            asm volatile("s_waitcnt vmcnt(0)" ::: "memory");
        }
    }
    __syncthreads();
}

template <int PH>
__device__ __forceinline__ void do_phase(const Params& p, const int l, LAS unsigned char* lds) {
    const int G = gridDim.x, cb = blockIdx.x;
    unsigned char* ws = p.ws;
    float* MOD = (float*)(ws + OFF_MOD);
    float* XB = (float*)(ws + OFF_XB);
    bf16_t* HX = (bf16_t*)(ws + OFF_HX);
    const float* modl = MOD + l * 3 * 12288;
    const float* srcL = (l == 0) ? p.x : XB;
    const float* srcC = (l == 0) ? p.ctx : XB + (size_t)ML * 2048;
    const int Mx = (l == 0) ? MT : ML;
    if constexpr (PH == 0) { phase_mod(p, lds); __syncthreads(); phase_convert(p, 0, lds, 0, 3328, cb, G); }
    if constexpr (PH == 1) { build_wx1(p, l); build_wx2(p, l);
        phase_norm(srcL, srcC, p.norm_mix_w + l * 2048, modl, 0, 2048, HX, MT, (const float*)(ws + OFF_PREP), (l == 1) ? 16 : 0, MOD + 2 * 12288 + 5 * 2048, nullptr); }
    if constexpr (PH == 2) { pg8::Gemm g{HX, (const bf16_t*)(ws + OFF_WIN), MT, INP, 2048, 2048, 2048}; pg8::Sched S; S.init(MT, INP, G, cb, 1);
        pg8::EpiB16<0, INP> E{(bf16_t*)(ws + OFF_U), nullptr}; pg8::gemm_phase(lds, g, S, E); }
    if constexpr (PH == 13) { build_ax1(p); build_xc(p, l); build_kk_la(p, l); }
    if constexpr (PH == 14) { pg8::Gemm g{(const bf16_t*)(ws + OFF_AX1), (const bf16_t*)(ws + OFF_WX1), MT, 2560, 384, 384, 384}; pg8::Sched S; S.init(MT, 2560, G, cb, 1);
        pg8::EpiRWX E{(bf16_t*)(ws + OFF_LW), (bf16_t*)(ws + OFF_AA), (bf16_t*)(ws + OFF_GV), p.rw_w0 + l * 1024, p.rw_a0 + l * 1024}; pg8::gemm_phase(lds, g, S, E); }
    if constexpr (PH == 15) { pg8::Gemm g{(const bf16_t*)(ws + OFF_XC), (const bf16_t*)(ws + OFF_WX2), MT, 2048, 512, 512, 512}; pg8::Sched S; S.init(MT, 2048, G, cb, 1);
        pg8::EpiGate E{(bf16_t*)(ws + OFF_GATES), p.lru_b_a + l * 1024, p.lru_b_x + l * 1024}; pg8::gemm_phase(lds, g, S, E); }
    if constexpr (PH == 16) phase_prep(p, l, lds, 1);
    if constexpr (PH == 3) phase_prep(p, l, lds, 2);
    if constexpr (PH == 4) phase_scan(p, l, lds);
#ifdef SCAN_PROBE_MASK
    if constexpr (PH == 14) phase_scan(p, l, lds, SCAN_PROBE_MASK);
#endif
    if constexpr (PH == 5) phase_post(p, l, lds);
    if constexpr (PH == 6) { pg8::Gemm g{HX, (const bf16_t*)(ws + OFF_WGT), Mx, 8192, 2048, 2048, 2048}; pg8::Sched S; S.init(Mx, 8192, G, cb, 1);
        pg8::EpiB16<1, 8192> E{(bf16_t*)(ws + OFF_G), p.gate_b + l * 8192}; pg8::gemm_phase(lds, g, S, E); }
    if constexpr (PH == 7) { pg8::Gemm g{(const bf16_t*)(ws + OFF_YS), (const bf16_t*)(ws + OFF_WBR), Mx, 2048, 512, 2048, 512}; pg8::Sched S; S.init(Mx, 2048, G, cb, 4);
        pg8::EpiBr E{(const bf16_t*)(ws + OFF_G), (bf16_t*)(ws + OFF_ACC)}; pg8::gemm_phase(lds, g, S, E); }
    if constexpr (PH == 8) { { pg8::Gemm g{(const bf16_t*)(ws + OFF_ACC), (const bf16_t*)(ws + OFF_WOUT), ML, 2048, 2048, 2048, 2048}; pg8::Sched S; S.init(ML, 2048, G, cb, 1);
          pg8::EpiRes E{srcL, srcC, XB, modl, 2 * 2048}; pg8::gemm_phase(lds, g, S, E); }
        if (l == 0) { __syncthreads(); pg8::Gemm g{(const bf16_t*)(ws + OFF_ACC), (const bf16_t*)(ws + OFF_WOUT), MT, 2048, 256, 2048, 2048}; pg8::Sched S; S.init_split(64, 2, 2048, 8, 256, G, cb);
          pg8::EpiPart E{(float*)(ws + OFF_PREP), 256}; pg8::gemm_phase(lds, g, S, E); } }
    if constexpr (PH == 9) phase_norm(XB, (l == 0) ? p.ctx : XB + (size_t)ML * 2048, p.norm_ffn_w + l * 2048, modl, 3 * 2048, 4 * 2048, HX, Mx, (const float*)(ws + OFF_PREP), (l == 0) ? 8 : 0, modl + 2 * 12288 + 2 * 2048, XB);
    if constexpr (PH == 10) { pg8::Gemm g{HX, (const bf16_t*)(ws + OFF_W1), Mx, 8192, 2048, 2048, 2048}; pg8::Sched S; S.init(Mx, 8192, G, cb, 1);
        pg8::EpiB16<2, 8192> E{(bf16_t*)(ws + OFF_F), nullptr}; pg8::gemm_phase(lds, g, S, E); }
    if constexpr (PH == 11) { { pg8::Gemm g{(const bf16_t*)(ws + OFF_F), (const bf16_t*)(ws + OFF_W2), ML, 2048, 8192, 8192, 8192}; pg8::Sched S; S.init(ML, 2048, G, cb, 1);
          pg8::EpiRes E{XB, XB + (size_t)ML * 2048, XB, modl, 5 * 2048}; pg8::gemm_phase(lds, g, S, E); }
        if (l == 0) { __syncthreads(); pg8::Gemm g{(const bf16_t*)(ws + OFF_F), (const bf16_t*)(ws + OFF_W2), MT, 2048, 512, 8192, 8192}; pg8::Sched S; S.init_split(64, 2, 2048, 16, 512, G, cb);
          pg8::EpiPart E{(float*)(ws + OFF_PREP), 512}; pg8::gemm_phase(lds, g, S, E); } }
    if constexpr (PH == 12) phase_final_norm(XB, p.final_norm_w, p.out);
}

#ifndef SINGLE_LAUNCH
#define SINGLE_LAUNCH 1
#endif

#if SINGLE_LAUNCH
__global__ void __launch_bounds__(512, 2) mega(Params p) {
    extern __shared__ __attribute__((aligned(16))) unsigned char smem[];
    LAS unsigned char* lds = (LAS unsigned char*)smem;
    cg::grid_group grid = cg::this_grid();
    volatile LAS unsigned* bst = (volatile LAS unsigned*)(lds + LDS_BYTES - 16);
    if (threadIdx.x < 4) bst[threadIdx.x] = 0u;
    __syncthreads();
    const XcdBarrier xbar = xcd_barrier_post((unsigned*)(p.ws + OFF_BAR), bst);
#ifndef DBL_MASK
#define DBL_MASK 0
#endif
#define RUNPH(ph, l) do { do_phase<ph>(p, l, lds); xcd_barrier(xbar, (unsigned*)(p.ws + OFF_BAR)); if (DBL_MASK & (1 << (ph))) { do_phase<ph>(p, l, lds); xcd_barrier(xbar, (unsigned*)(p.ws + OFF_BAR)); } } while (0)
    if (p.ws == nullptr) grid.sync();
    do_phase<0>(p, 0, lds); xcd_barrier(xbar, (unsigned*)(p.ws + OFF_BAR));
    for (int l = 0; l < 2; ++l) {
        RUNPH(1, l); RUNPH(2, l); RUNPH(13, l); do_phase<14>(p, l, lds); __syncthreads(); do_phase<15>(p, l, lds); xcd_barrier(xbar, (unsigned*)(p.ws + OFF_BAR)); RUNPH(3, l); RUNPH(4, l);
#ifdef SCAN_PROBE_MASK
        do_phase<14>(p, l, lds); xcd_barrier(xbar, (unsigned*)(p.ws + OFF_BAR));
#endif
        RUNPH(5, l); RUNPH(6, l); RUNPH(7, l); RUNPH(8, l); RUNPH(9, l); RUNPH(10, l); RUNPH(11, l);
    }
    do_phase<12>(p, 0, lds);
}
#else
template <int PH> __global__ void __launch_bounds__(512, 2) k_phase(Params p, int l) {
    extern __shared__ __attribute__((aligned(16))) unsigned char smem[];
    do_phase<PH>(p, l, (LAS unsigned char*)smem);
}
template <int PH> static void launch_phase(const Params& p, int l, int grid, hipStream_t stream) {
    static bool attr = false;
    if (!attr) { (void)hipFuncSetAttribute((const void*)k_phase<PH>, hipFuncAttributeMaxDynamicSharedMemorySize, LDS_BYTES); attr = true; }
    hipLaunchKernelGGL(k_phase<PH>, dim3(grid), dim3(512), LDS_BYTES, stream, p, l);
}
#endif

extern "C" void kernel_launch(void* const* d_in, const int* in_sizes, int n_in, void* d_out, int out_size, void* d_ws, size_t ws_size, hipStream_t stream) {
    static int grid_blocks = 0;
    if (grid_blocks == 0) {
        if (n_in != 38 || ws_size < WS_END) { fprintf(stderr, "kernel_launch: need 38 inputs and >= %zu bytes of workspace (got %d, %zu)\n", (size_t)WS_END, n_in, ws_size); grid_blocks = -1; return; }
        int dev = 0, cus = 0;
        (void)hipGetDevice(&dev);
        (void)hipDeviceGetAttribute(&cus, hipDeviceAttributeMultiprocessorCount, dev);
#if SINGLE_LAUNCH
        int per_cu = 0;
        if (hipFuncSetAttribute((const void*)mega, hipFuncAttributeMaxDynamicSharedMemorySize, LDS_BYTES) != hipSuccess) { fprintf(stderr, "kernel_launch: hipFuncSetAttribute failed\n"); grid_blocks = -1; return; }
        if (hipOccupancyMaxActiveBlocksPerMultiprocessor(&per_cu, (const void*)mega, 512, LDS_BYTES) != hipSuccess || per_cu < 1) { fprintf(stderr, "kernel_launch: occupancy query says %d blocks per CU\n", per_cu); (void)hipGetLastError(); per_cu = 1; }
        grid_blocks = cus * per_cu;
#else
        grid_blocks = cus;
#endif
    }
    if (grid_blocks < 0) return;
    Params p{};
    const float** dst = (const float**)&p;
    for (int i = 0; i < 38; ++i) dst[i] = (const float*)d_in[i];
    p.out = (float*)d_out; p.ws = (unsigned char*)d_ws;
#if SINGLE_LAUNCH
    (void)hipMemsetAsync((unsigned char*)d_ws + OFF_BAR, 0, 16384, stream);
    void* args[] = {&p};
    hipError_t e = hipLaunchCooperativeKernel((const void*)mega, dim3(grid_blocks), dim3(512), args, LDS_BYTES, stream);
    if (e != hipSuccess) fprintf(stderr, "cooperative launch failed: %s (grid %d)\n", hipGetErrorString(e), grid_blocks);
#else
    const int g = grid_blocks;
    launch_phase<0>(p, 0, g, stream);
    for (int l = 0; l < 2; ++l) {
        launch_phase<1>(p, l, g, stream); launch_phase<2>(p, l, g, stream); launch_phase<3>(p, l, g, stream); launch_phase<4>(p, l, g, stream);
        launch_phase<5>(p, l, g, stream); launch_phase<6>(p, l, g, stream); launch_phase<7>(p, l, g, stream); launch_phase<8>(p, l, g, stream);
        launch_phase<9>(p, l, g, stream); launch_phase<10>(p, l, g, stream); launch_phase<11>(p, l, g, stream);
    }
    launch_phase<12>(p, 0, g, stream);
#endif
}
```

```cpp
#include <hip/hip_runtime.h>
#include <hip/hip_cooperative_groups.h>
#include <cstdio>
namespace cg = cooperative_groups;

#define LAS __attribute__((address_space(3)))
typedef unsigned short bf16_t;
typedef short bf16x8 __attribute__((ext_vector_type(8)));
typedef float f32x4 __attribute__((ext_vector_type(4)));
typedef float f32x2 __attribute__((ext_vector_type(2)));
typedef unsigned u32x4 __attribute__((ext_vector_type(4)));
typedef unsigned u32x2 __attribute__((ext_vector_type(2)));

constexpr int D = 2048, SEQ = 8192, CTX = 256, DFF = 8192;
constexpr int ML = 2 * SEQ;
constexpr int MC = 2 * CTX;
constexpr int MT = ML + MC;
constexpr int INC = 6576, INP = 6656;
constexpr int C_RW_R = 0, C_RW_K = 512, C_RW_V = 1024, C_RW_W = 1536, C_RW_A = 1664, C_RW_G = 1792, C_LRU_X = 1920, C_LRU_G = 2432,
              C_GLA_Q = 2944, C_GLA_K = 3200, C_GLA_V = 3456, C_GLA_R = 3968, C_GLA_W = 4480, C_ML_Q = 4512, C_ML_K = 5024, C_ML_V = 5536,
              C_ML_O = 6048, C_ML_I = 6560, C_ML_F = 6568;
constexpr float EPS = 1e-6f;
constexpr int LDS_BYTES = 147456;
constexpr int NCH = 264;

constexpr size_t AL(size_t x) { return (x + 255) & ~(size_t)255; }
constexpr size_t OFF_MOD = 0;
constexpr size_t OFF_WIN = AL(OFF_MOD + (size_t)2 * 3 * 12288 * 4);
constexpr size_t OFF_WGT = OFF_WIN + (size_t)INP * 2048 * 2;
constexpr size_t OFF_WBR = OFF_WGT + (size_t)8192 * 2048 * 2;
constexpr size_t OFF_WOUT = OFF_WBR + (size_t)4 * 2048 * 512 * 2;
constexpr size_t OFF_W1 = OFF_WOUT + (size_t)2048 * 2048 * 2;
constexpr size_t OFF_W2 = OFF_W1 + (size_t)8192 * 2048 * 2;
constexpr size_t OFF_XB = OFF_W2 + (size_t)2048 * 8192 * 2;
constexpr size_t OFF_HX = OFF_XB + (size_t)MT * 2048 * 4;
constexpr size_t OFF_BIG = OFF_HX + (size_t)MT * 2048 * 2;
constexpr size_t OFF_U = OFF_BIG;
constexpr size_t SZ_Y = (size_t)2 * MT * 512 * 2;
constexpr size_t OFF_YRW = OFF_U + (size_t)MT * INP * 2;
constexpr size_t OFF_YGL = OFF_YRW + SZ_Y;
constexpr size_t OFF_YML = OFF_YGL + SZ_Y;
constexpr size_t OFF_DEN = OFF_YML + SZ_Y;
constexpr size_t OFF_PREP = AL(OFF_DEN + (size_t)2 * MT * 4 * 4);
constexpr size_t OFF_LW = OFF_PREP;
constexpr size_t OFF_AA = OFF_LW + SZ_Y;
constexpr size_t OFF_NKK = OFF_AA + SZ_Y;
constexpr size_t OFF_LA = OFF_NKK + (size_t)MT * 512 * 2;
constexpr size_t OFF_LACUM = OFF_LA + (size_t)2 * MT * 256 * 2;
constexpr size_t OFF_LHLOC = OFF_LACUM + SZ_Y;
constexpr size_t SZ_LS = (size_t)2 * 2 * NCH * 512 * 4;
constexpr size_t OFF_APROD = OFF_LHLOC + SZ_Y;
constexpr size_t OFF_HEND = OFF_APROD + SZ_LS;
constexpr size_t OFF_CARRY = OFF_HEND + SZ_LS;
constexpr size_t OFF_BAR = OFF_CARRY + SZ_LS;
constexpr size_t OFF_GV = OFF_BAR + 16384;
constexpr size_t OFF_WX1 = OFF_GV + (size_t)MT * 512 * 2;
constexpr size_t OFF_WX2 = OFF_WX1 + (size_t)2560 * 384 * 2;
constexpr size_t WS_END = OFF_WX2 + (size_t)2048 * 512 * 2;
constexpr size_t OFF_XC = OFF_YML + AL((size_t)MT * 384 * 2);
constexpr size_t OFF_GATES = OFF_YRW;
static_assert(OFF_XC + (size_t)MT * 512 * 2 <= OFF_YML + SZ_Y, "XC alias");
constexpr size_t OFF_AX1 = OFF_YML;
constexpr size_t OFF_YS = OFF_PREP;
constexpr size_t OFF_G = OFF_BIG;
constexpr size_t OFF_ACC = OFF_HX;
constexpr size_t OFF_F = OFF_BIG;
static_assert(OFF_YS + (size_t)MT * 2048 * 2 <= OFF_LACUM, "YS alias");
static_assert(OFF_G + (size_t)MT * 8192 * 2 <= OFF_PREP, "G alias");

struct Params {
    const float *x, *c, *ctx, *c_ctx, *ada_w, *ada_b, *norm_mix_w, *w_in, *rw_w_up, *rw_w0, *rw_a_up, *rw_a0, *rw_g_up, *rw_k_k, *rw_k_a, *rw_r_k, *rw_ln_w,
        *lru_conv_w, *lru_conv_b, *lru_w_a, *lru_b_a, *lru_w_x, *lru_b_x, *lru_lambda, *gla_w_up, *gla_w0, *gla_ln_w, *ml_i_b, *ml_f_b, *ml_ln_w,
        *br_w, *gate_w, *gate_b, *out_w, *norm_ffn_w, *ffn_w1, *ffn_w2, *final_norm_w;
    float* out;
    unsigned char* ws;
};

__device__ __forceinline__ int otid() { int t = threadIdx.x; asm volatile("" : "+v"(t)); return t; }
__device__ __forceinline__ float bf2f(bf16_t v) { return __uint_as_float(((unsigned)v) << 16); }
__device__ __forceinline__ unsigned cvt_pk_bf16(float lo, float hi) { unsigned r; asm("v_cvt_pk_bf16_f32 %0, %1, %2" : "=v"(r) : "v"(lo), "v"(hi)); return r; }
__device__ __forceinline__ bf16_t f2bf(float x) { return (bf16_t)(cvt_pk_bf16(x, 0.f) & 0xffffu); }
__device__ __forceinline__ float sigm(float x) { return 1.0f / (1.0f + __expf(-x)); }
__device__ __forceinline__ float sigm_fast(float x) { const float d = 1.0f + __expf(-x); float r; asm volatile("s_nop 1\n\tv_rcp_f32 %0, %1\n\ts_nop 1" : "=&v"(r) : "v"(d)); return r; }
__device__ __forceinline__ float rcp_g(float d) { float r; asm volatile("s_nop 1\n\tv_rcp_f32 %0, %1\n\ts_nop 1" : "=&v"(r) : "v"(d)); return r; }
__device__ __forceinline__ float sqrt_g(float d) { float r; asm volatile("s_nop 1\n\tv_sqrt_f32 %0, %1\n\ts_nop 1" : "=&v"(r) : "v"(d)); return r; }
__device__ __forceinline__ float gelu_fast(float x) { const float t = __expf(1.5957691216057308f * (x + 0.044715f * x * x * x)); return x - x * rcp_g(t + 1.0f); }
__device__ __forceinline__ float tanh_(float x) { const float t = __expf(2.0f * x); return 1.0f - 2.0f / (t + 1.0f); }
__device__ __forceinline__ float gelu_tanh(float x) { return 0.5f * x * (1.0f + tanh_(0.7978845608028654f * (x + 0.044715f * x * x * x))); }
__device__ __forceinline__ float log_sigm(float x) { return fminf(x, 0.f) - log1pf(__expf(-fabsf(x))); }
__device__ __forceinline__ float softplus_(float y) { return fmaxf(y, 0.f) + log1pf(__expf(-fabsf(y))); }
template <int CTRL> __device__ __forceinline__ float dppmov(float x) { return __int_as_float(__builtin_amdgcn_update_dpp(0, __float_as_int(x), CTRL, 0xF, 0xF, true)); }
__device__ __forceinline__ float red16(float x) {
    x += dppmov<0xB1>(x); x += dppmov<0x4E>(x); x += dppmov<0x141>(x); x += dppmov<0x140>(x); return x;
}
__device__ __forceinline__ float red8(float x) { x += dppmov<0xB1>(x); x += dppmov<0x4E>(x); x += dppmov<0x141>(x); return x; }
__device__ __forceinline__ float wave_sum(float v) {
    v = red16(v);
    const float a = __int_as_float(__builtin_amdgcn_readlane(__float_as_int(v), 0)), b = __int_as_float(__builtin_amdgcn_readlane(__float_as_int(v), 16)),
                c = __int_as_float(__builtin_amdgcn_readlane(__float_as_int(v), 32)), d = __int_as_float(__builtin_amdgcn_readlane(__float_as_int(v), 48));
    return (a + b) + (c + d);
}
__device__ __forceinline__ void unpack4(const u32x2 w, float (&f)[4]) { f[0] = __uint_as_float(w.x << 16); f[1] = __uint_as_float(w.x & 0xffff0000u); f[2] = __uint_as_float(w.y << 16); f[3] = __uint_as_float(w.y & 0xffff0000u); }
__device__ __forceinline__ void unpack8(const u32x4 w, float (&f)[8]) {
    f[0] = __uint_as_float(w.x << 16); f[1] = __uint_as_float(w.x & 0xffff0000u); f[2] = __uint_as_float(w.y << 16); f[3] = __uint_as_float(w.y & 0xffff0000u);
    f[4] = __uint_as_float(w.z << 16); f[5] = __uint_as_float(w.z & 0xffff0000u); f[6] = __uint_as_float(w.w << 16); f[7] = __uint_as_float(w.w & 0xffff0000u);
}
__device__ __forceinline__ u32x4 pack8(const float (&f)[8]) { u32x4 w; w.x = cvt_pk_bf16(f[0], f[1]); w.y = cvt_pk_bf16(f[2], f[3]); w.z = cvt_pk_bf16(f[4], f[5]); w.w = cvt_pk_bf16(f[6], f[7]); return w; }

namespace pg8 {
constexpr int BM = 256, BK = 64, HALF = 128, HTB = HALF * BK * 2, STAGE_BYTES = 8 * HTB, NXCD = 8, WGM = 8;
__device__ __forceinline__ int lds_byte(int r, int c) { const int st = (r >> 4) * 2 + (c >> 5), rr = r & 15, cc = c & 31, ob = rr * 64 + cc * 2; return st * 1024 + (ob ^ (((ob >> 9) & 1) << 5)); }
__device__ __forceinline__ void stage_rc(int b, int& R, int& C) { const int st = b / 1024, sb = b % 1024, swz = sb ^ (((sb >> 9) & 1) << 5); R = (st >> 1) * 16 + swz / 64; C = (st & 1) * 32 + (swz % 64) / 2; }
__device__ __forceinline__ int perm32(int rho) { const int n = rho >> 4, i = rho & 15; return 8 * (i >> 2) + 4 * n + (i & 3); }

struct Unit { int pm, pn, pb, ak, br, bk; };
struct Gemm { const bf16_t* A; const bf16_t* Bt; int M, N, K, lda, ldb; };
struct Sched {
    int nM, nN, nwg, G, c, grp, split, pm0, ksub;
    __device__ void init(int M, int N, int G_, int c_, int grp_) { nM = M / BM; nN = N / BM; nwg = nM * nN; G = G_; c = c_; grp = grp_; split = 0; pm0 = 0; ksub = 0; }
    __device__ void init_split(int pm0_, int nMt, int N, int S, int ksub_, int G_, int c_) { nM = nMt; nN = N / BM; nwg = nMt * nN * S; G = G_; c = c_; grp = 1; split = S; pm0 = pm0_; ksub = ksub_; }
    __device__ bool next(int i, Unit& u) const {
        const int q = (grp == 4) ? (i >> 2) : i, br = (grp == 4) ? (i & 3) : 0;
        const long L = (long)q * G + c; if (L >= nwg) return false;
        if (split) { const int ks = (int)L % split, tile = (int)L / split; u.pm = pm0 + tile / nN; u.pn = tile % nN; u.pb = u.pn; u.ak = ks * ksub; u.bk = u.ak; u.br = 0; return true; }
        int wgid = (int)L; { const int qq = nwg / NXCD, r = nwg % NXCD, xcd = wgid % NXCD, off = wgid / NXCD; wgid = (xcd < r ? xcd * (qq + 1) : r * (qq + 1) + (xcd - r) * qq) + off; }
        const int nig = WGM * nN, gid = wgid / nig, fm = gid * WGM, gsz = (nM - fm) < WGM ? (nM - fm) : WGM;
        u.pm = fm + ((wgid % nig) % gsz); u.pn = (wgid % nig) / gsz; u.br = br; u.pb = br * nN + u.pn; u.ak = br * 512; u.bk = 0; return true;
    }
};

template <class Epi>
__device__ __forceinline__ void gemm_phase(LAS unsigned char* lds, const Gemm g, const Sched& S, const Epi& E) {
    const int tid = otid(), wid = __builtin_amdgcn_readfirstlane(tid >> 6), lane = tid & 63, wr = wid >> 2, wc = wid & 3, fr = lane & 15, fq = lane >> 4;
    int nt = g.K / BK; asm volatile("" : "+s"(nt));
    unsigned voffA[2], voffB[2];
#pragma unroll
    for (int i = 0; i < 2; ++i) { int R, C; stage_rc(tid * 16 + i * 8192, R, C); const int Rb = Epi::PERM ? ((R & ~31) + perm32(R & 31)) : R;
        voffA[i] = (unsigned)(R * g.lda + C) * 2u; voffB[i] = (unsigned)(Rb * g.ldb + C) * 2u; }
    const size_t kstep = (size_t)(BK * 2);
    const size_t hstepA = (size_t)HALF * g.lda * 2, hstepB = (size_t)HALF * g.ldb * 2;
    const unsigned ldsw = (unsigned)wid * 1024u;
    const int aoff = lds_byte(wr * 64 + fr, fq * 8), boff = lds_byte(wc * 32 + fr, fq * 8);
#define PG8_SA(b, h) (((b) * 2 + (h)) * HTB)
#define PG8_SB(b, h) ((4 + (b) * 2 + (h)) * HTB)
#define PG8_STAGE(bufoff, gbase, voff) do { _Pragma("unroll") for (int _i = 0; _i < 2; ++_i) \
        __builtin_amdgcn_global_load_lds((const unsigned*)((const char*)(gbase) + (voff)[_i]), (LAS unsigned*)(lds + (bufoff) + ldsw + _i * 8192), 16, 0, 0); } while (0)
#define PG8_LDA(dst, b, h) do { _Pragma("unroll") for (int m = 0; m < 4; ++m) _Pragma("unroll") for (int k = 0; k < 2; ++k) dst[m][k] = *(const LAS bf16x8*)(lds + PG8_SA(b, h) + aoff + m * 2048 + k * 1024); } while (0)
#define PG8_LDB(dst, b, h) do { _Pragma("unroll") for (int n = 0; n < 2; ++n) _Pragma("unroll") for (int k = 0; k < 2; ++k) dst[n][k] = *(const LAS bf16x8*)(lds + PG8_SB(b, h) + boff + n * 2048 + k * 1024); } while (0)
#define PG8_MMA(ai, bj, At, Bt) do { __builtin_amdgcn_s_setprio(1); _Pragma("unroll") for (int m = 0; m < 4; ++m) _Pragma("unroll") for (int n = 0; n < 2; ++n) _Pragma("unroll") for (int k = 0; k < 2; ++k) \
        acc[ai][bj][m][n] = __builtin_amdgcn_mfma_f32_16x16x32_bf16(Bt[n][k], At[m][k], acc[ai][bj][m][n], 0, 0, 0); __builtin_amdgcn_s_setprio(0); } while (0)
#define PG8_WAIT_V(n) asm volatile("s_waitcnt vmcnt(" #n ")" ::: "memory")
#define PG8_WAIT_L(n) asm volatile("s_waitcnt lgkmcnt(" #n ")" ::: "memory")
#define PG8_BAR __builtin_amdgcn_s_barrier()
#define PG8_SCHED __builtin_amdgcn_sched_barrier(0)
    Unit cur, nxt; int ui = 0;
    if (!S.next(0, cur)) return;
    f32x4 acc[2][2][4][2];
#pragma unroll
    for (int a = 0; a < 2; ++a)
#pragma unroll
        for (int b = 0; b < 2; ++b)
#pragma unroll
            for (int m = 0; m < 4; ++m)
#pragma unroll
                for (int n = 0; n < 2; ++n) acc[a][b][m][n] = (f32x4){0.f, 0.f, 0.f, 0.f};
    bf16x8 At[4][2], B0[2][2], B1[2][2];
    const char* cA = (const char*)g.A + (size_t)cur.pm * 2 * hstepA + (size_t)cur.ak * 2;
    const char* cB = (const char*)g.Bt + (size_t)cur.pb * 2 * hstepB + (size_t)cur.bk * 2;
    PG8_STAGE(PG8_SB(0, 0), cB, voffB); PG8_STAGE(PG8_SA(0, 0), cA, voffA); PG8_STAGE(PG8_SB(0, 1), cB + hstepB, voffB); PG8_STAGE(PG8_SA(0, 1), cA + hstepA, voffA);
    if (wr == 1) PG8_BAR;
    PG8_WAIT_V(4); PG8_BAR;
    PG8_STAGE(PG8_SB(1, 0), cB + kstep, voffB); PG8_STAGE(PG8_SA(1, 0), cA + kstep, voffA); PG8_STAGE(PG8_SB(1, 1), cB + hstepB + kstep, voffB);
    PG8_WAIT_V(6); PG8_BAR;
    for (;;) {
        const bool has_next = S.next(ui + 1, nxt);
        const char* nA = has_next ? (const char*)g.A + (size_t)nxt.pm * 2 * hstepA + (size_t)nxt.ak * 2 : cA;
        const char* nB = has_next ? (const char*)g.Bt + (size_t)nxt.pb * 2 * hstepB + (size_t)nxt.bk * 2 : cB;
        for (int t = 0; t < nt; t += 2) {
            const bool last = (t == nt - 2);
            const char* a1 = cA + (size_t)(t + 1) * kstep;
            const char* a2 = last ? nA : cA + (size_t)(t + 2) * kstep; const char* b2 = last ? nB : cB + (size_t)(t + 2) * kstep;
            const char* a3 = a2 + kstep; const char* b3 = b2 + kstep;
            PG8_LDB(B0, 0, 0); PG8_SCHED; PG8_LDA(At, 0, 0); PG8_STAGE(PG8_SA(1, 1), a1 + hstepA, voffA);
            PG8_WAIT_L(8); PG8_BAR; PG8_WAIT_L(0); PG8_MMA(0, 0, At, B0); PG8_BAR; PG8_SCHED;
            PG8_LDB(B1, 0, 1); PG8_STAGE(PG8_SB(0, 0), b2, voffB);
            PG8_BAR; PG8_WAIT_L(0); PG8_MMA(0, 1, At, B1); PG8_BAR;
            PG8_LDA(At, 0, 1); PG8_STAGE(PG8_SA(0, 0), a2, voffA);
            PG8_BAR; PG8_WAIT_L(0); PG8_MMA(1, 0, At, B0); PG8_BAR; PG8_SCHED;
            PG8_STAGE(PG8_SB(0, 1), b2 + hstepB, voffB);
            PG8_WAIT_V(6); PG8_BAR; PG8_MMA(1, 1, At, B1); PG8_BAR;
            PG8_LDB(B0, 1, 0); PG8_SCHED; PG8_LDA(At, 1, 0); PG8_STAGE(PG8_SA(0, 1), a2 + hstepA, voffA);
            PG8_WAIT_L(8); PG8_BAR; PG8_WAIT_L(0); PG8_MMA(0, 0, At, B0); PG8_BAR; PG8_SCHED;
            PG8_LDB(B1, 1, 1); PG8_STAGE(PG8_SB(1, 0), b3, voffB);
            PG8_BAR; PG8_WAIT_L(0); PG8_MMA(0, 1, At, B1); PG8_BAR;
            PG8_LDA(At, 1, 1); PG8_STAGE(PG8_SA(1, 0), a3, voffA);
            PG8_BAR; PG8_WAIT_L(0); PG8_MMA(1, 0, At, B0); PG8_BAR; PG8_SCHED;
            PG8_STAGE(PG8_SB(1, 1), b3 + hstepB, voffB);
            PG8_WAIT_V(6); PG8_BAR; PG8_MMA(1, 1, At, B1); PG8_BAR;
        }
        const bool keep = E(acc, cur, wr, wc, fr, fq);
        if (!has_next) break;
        if (!keep) {
#pragma unroll
            for (int a = 0; a < 2; ++a)
#pragma unroll
                for (int b = 0; b < 2; ++b)
#pragma unroll
                    for (int m = 0; m < 4; ++m)
#pragma unroll
                        for (int n = 0; n < 2; ++n) acc[a][b][m][n] = (f32x4){0.f, 0.f, 0.f, 0.f};
        }
        cur = nxt; cA = nA; cB = nB; ++ui;
    }
    PG8_WAIT_V(0);
    if (wr == 0) PG8_BAR;
    PG8_BAR;
#undef PG8_SA
#undef PG8_SB
#undef PG8_STAGE
#undef PG8_LDA
#undef PG8_LDB
#undef PG8_MMA
#undef PG8_WAIT_V
#undef PG8_WAIT_L
#undef PG8_BAR
#undef PG8_SCHED
}

template <int ACT  , int ldc> struct EpiB16 {
    static constexpr bool PERM = true;
    bf16_t* O; const float* bias;
    __device__ __forceinline__ bool operator()(f32x4 (&acc)[2][2][4][2], const Unit& u, int wr, int wc, int fr, int fq) const {
        const int row0 = u.pm * BM + wr * 64 + fr, col0 = u.pn * BM + wc * 32 + 8 * fq;
        f32x4 bv[2][2];
#pragma unroll
        for (int bj = 0; bj < 2; ++bj)
#pragma unroll
            for (int n = 0; n < 2; ++n) bv[bj][n] = (ACT == 1) ? *(const f32x4*)(bias + col0 + bj * HALF + 4 * n) : (f32x4){0.f, 0.f, 0.f, 0.f};
#pragma unroll
        for (int ai = 0; ai < 2; ++ai)
#pragma unroll
            for (int m = 0; m < 4; ++m) { bf16_t* rowp = O + (size_t)(row0 + ai * HALF + m * 16) * ldc + col0;
#pragma unroll
                for (int bj = 0; bj < 2; ++bj) { f32x4 v0 = acc[ai][bj][m][0], v1 = acc[ai][bj][m][1];
                    if (ACT == 1) {
                        v0 += bv[bj][0]; v1 += bv[bj][1];
#pragma unroll
                        for (int j = 0; j < 4; ++j) { v0[j] = sigm_fast(v0[j]); v1[j] = sigm_fast(v1[j]); } }
                    if (ACT == 2) {
#pragma unroll
                        for (int j = 0; j < 4; ++j) { const float a = fmaxf(v0[j], 0.f), b = fmaxf(v1[j], 0.f); v0[j] = a * a; v1[j] = b * b; } }
                    u32x4 w; w.x = cvt_pk_bf16(v0[0], v0[1]); w.y = cvt_pk_bf16(v0[2], v0[3]); w.z = cvt_pk_bf16(v1[0], v1[1]); w.w = cvt_pk_bf16(v1[2], v1[3]);
                    *(u32x4*)(rowp + bj * HALF) = w; } }
        return false;
    }
};
struct EpiRWX {
    static constexpr bool PERM = true;
    bf16_t* LWp; bf16_t* AAp; bf16_t* GVp; const float* w0; const float* a0;
    __device__ __forceinline__ bool operator()(f32x4 (&acc)[2][2][4][2], const Unit& u, int wr, int wc, int fr, int fq) const {
        const int row0 = u.pm * BM + wr * 64 + fr, t = u.pn >> 1, cc0 = (u.pn & 1) * 256 + wc * 32 + 8 * fq, z = t & 1;
        const float* bias = (t < 2) ? w0 + z * 512 : a0 + z * 512;
        bf16_t* base = (t < 2) ? LWp + (size_t)z * MT * 512 : ((t < 4) ? AAp + (size_t)z * MT * 512 : GVp);
        f32x4 bv[2][2];
#pragma unroll
        for (int bj = 0; bj < 2; ++bj)
#pragma unroll
            for (int n = 0; n < 2; ++n) bv[bj][n] = (t < 4) ? *(const f32x4*)(bias + cc0 + bj * HALF + 4 * n) : (f32x4){0.f, 0.f, 0.f, 0.f};
        const float sc = (t < 2) ? -0.6065306597f : 1.0f;
#pragma unroll
        for (int ai = 0; ai < 2; ++ai)
#pragma unroll
            for (int m = 0; m < 4; ++m) { bf16_t* rowp = base + (size_t)(row0 + ai * HALF + m * 16) * 512 + cc0;
#pragma unroll
                for (int bj = 0; bj < 2; ++bj) { f32x4 v0 = acc[ai][bj][m][0] + bv[bj][0], v1 = acc[ai][bj][m][1] + bv[bj][1];
                    if (t < 4) {
#pragma unroll
                        for (int j = 0; j < 4; ++j) { v0[j] = sc * sigm_fast(v0[j]); v1[j] = sc * sigm_fast(v1[j]); } }
                    u32x4 w; w.x = cvt_pk_bf16(v0[0], v0[1]); w.y = cvt_pk_bf16(v0[2], v0[3]); w.z = cvt_pk_bf16(v1[0], v1[1]); w.w = cvt_pk_bf16(v1[2], v1[3]);
                    *(u32x4*)(rowp + bj * HALF) = w; } }
        return false;
    }
};
struct EpiGate {
    static constexpr bool PERM = true;
    bf16_t* O; const float* ba; const float* bx;
    __device__ __forceinline__ bool operator()(f32x4 (&acc)[2][2][4][2], const Unit& u, int wr, int wc, int fr, int fq) const {
        const int row0 = u.pm * BM + wr * 64 + fr, gz = u.pn >> 1, cc0 = (u.pn & 1) * 256 + wc * 32 + 8 * fq;
        const float* bias = ((gz >> 1) ? bx : ba) + (gz & 1) * 512;
        bf16_t* base = O + (size_t)gz * MT * 512;
        f32x4 bv[2][2];
#pragma unroll
        for (int bj = 0; bj < 2; ++bj)
#pragma unroll
            for (int n = 0; n < 2; ++n) bv[bj][n] = *(const f32x4*)(bias + cc0 + bj * HALF + 4 * n);
#pragma unroll
        for (int ai = 0; ai < 2; ++ai)
#pragma unroll
            for (int m = 0; m < 4; ++m) { bf16_t* rowp = base + (size_t)(row0 + ai * HALF + m * 16) * 512 + cc0;
#pragma unroll
                for (int bj = 0; bj < 2; ++bj) { f32x4 v0 = acc[ai][bj][m][0] + bv[bj][0], v1 = acc[ai][bj][m][1] + bv[bj][1];
#pragma unroll
                    for (int j = 0; j < 4; ++j) { v0[j] = sigm_fast(v0[j]); v1[j] = sigm_fast(v1[j]); }
                    u32x4 w; w.x = cvt_pk_bf16(v0[0], v0[1]); w.y = cvt_pk_bf16(v0[2], v0[3]); w.z = cvt_pk_bf16(v1[0], v1[1]); w.w = cvt_pk_bf16(v1[2], v1[3]);
                    *(u32x4*)(rowp + bj * HALF) = w; } }
        return false;
    }
};
struct EpiRes {
    static constexpr bool PERM = false;
    const float* srcL; const float* srcC; float* dst; const float* modl; int goff;
    __device__ __forceinline__ bool operator()(f32x4 (&acc)[2][2][4][2], const Unit& u, int wr, int wc, int fr, int fq) const {
        const int row0 = u.pm * BM + wr * 64 + fr, col0 = u.pn * BM + wc * 32 + 4 * fq;
        const int r = (u.pm < 64) ? (u.pm >> 5) : 2;
        const float* gp = modl + r * 12288 + goff + col0;
        f32x4 gv[2][2];
#pragma unroll
        for (int bj = 0; bj < 2; ++bj)
#pragma unroll
            for (int n = 0; n < 2; ++n) gv[bj][n] = *(const f32x4*)(gp + bj * HALF + n * 16);
#pragma unroll
        for (int ai = 0; ai < 2; ++ai)
#pragma unroll
            for (int m = 0; m < 4; ++m) { const int row = row0 + ai * HALF + m * 16;
                const float* sp = ((row < ML) ? srcL + (size_t)row * 2048 : srcC + (size_t)(row - ML) * 2048) + col0; float* dp = dst + (size_t)row * 2048 + col0;
#pragma unroll
                for (int bj = 0; bj < 2; ++bj)
#pragma unroll
                    for (int n = 0; n < 2; ++n) { const f32x4 xo = *(const f32x4*)(sp + bj * HALF + n * 16); *(f32x4*)(dp + bj * HALF + n * 16) = xo + gv[bj][n] * acc[ai][bj][m][n]; }
                asm volatile("" ::: "memory"); }
        return false;
    }
};
struct EpiPart {
    static constexpr bool PERM = false;
    float* part; int ksub;
    __device__ __forceinline__ bool operator()(f32x4 (&acc)[2][2][4][2], const Unit& u, int wr, int wc, int fr, int fq) const {
        const int row0 = u.pm * BM + wr * 64 + fr - ML, col0 = u.pn * BM + wc * 32 + 4 * fq, ks = u.ak / ksub;
#pragma unroll
        for (int ai = 0; ai < 2; ++ai)
#pragma unroll
            for (int m = 0; m < 4; ++m) { float* dp = part + ((size_t)ks * MC + (row0 + ai * HALF + m * 16)) * 2048 + col0;
#pragma unroll
                for (int bj = 0; bj < 2; ++bj)
#pragma unroll
                    for (int n = 0; n < 2; ++n) *(f32x4*)(dp + bj * HALF + n * 16) = acc[ai][bj][m][n]; }
        return false;
    }
};
struct EpiBr {
    static constexpr bool PERM = true;
    const bf16_t* G; bf16_t* O;
    __device__ __forceinline__ bool operator()(f32x4 (&acc)[2][2][4][2], const Unit& u, int wr, int wc, int fr, int fq) const {
        const int row0 = u.pm * BM + wr * 64 + fr, col0 = u.pn * BM + wc * 32 + 8 * fq;
        const bool lastb = (u.br == 3);
#pragma unroll
        for (int ai = 0; ai < 2; ++ai)
#pragma unroll
            for (int m = 0; m < 4; ++m) { const size_t row = (size_t)(row0 + ai * HALF + m * 16);
#pragma unroll
                for (int bj = 0; bj < 2; ++bj) {
                    const u32x4 gc = *(const u32x4*)(G + row * 8192 + u.br * 2048 + col0 + bj * HALF);
                    float fc[8]; unpack8(gc, fc);
                    if (!lastb) {
                        const u32x4 gn = *(const u32x4*)(G + row * 8192 + (u.br + 1) * 2048 + col0 + bj * HALF);
                        float fn[8]; unpack8(gn, fn);
#pragma unroll
                        for (int j = 0; j < 8; ++j) fc[j] = fc[j] * __builtin_amdgcn_rcpf(fmaxf(fn[j], 1e-30f));
                    }
                    f32x4 v0 = acc[ai][bj][m][0], v1 = acc[ai][bj][m][1];
#pragma unroll
                    for (int j = 0; j < 4; ++j) { v0[j] *= fc[j]; v1[j] *= fc[4 + j]; }
                    acc[ai][bj][m][0] = v0; acc[ai][bj][m][1] = v1;
                    if (lastb) { u32x4 w; w.x = cvt_pk_bf16(v0[0], v0[1]); w.y = cvt_pk_bf16(v0[2], v0[3]); w.z = cvt_pk_bf16(v1[0], v1[1]); w.w = cvt_pk_bf16(v1[2], v1[3]);
                        *(u32x4*)(O + row * 2048 + col0 + bj * HALF) = w; }
                }
                asm volatile("" ::: "memory"); }
        return !lastb;
    }
};
}

__device__ void phase_mod(const Params& p, LAS unsigned char* lds) {
    LAS float* sl = (LAS float*)lds;
    LAS float* red = (LAS float*)(lds + 24576);
    float* MOD = (float*)(p.ws + OFF_MOD);
    const int tid = otid();
    if ((int)blockIdx.x >= 192) return;
    for (int i = tid; i < 3 * 2048; i += 512) { const int r = i >> 11, k = i & 2047; const float v = (r < 2) ? p.c[r * 2048 + k] : p.c_ctx[k]; sl[i] = v * sigm(v); }
    __syncthreads();
    for (int item = blockIdx.x; item < 192; item += gridDim.x) {
        const int l = item / 96, cb = item % 96, cg4 = tid & 31, ksl = tid >> 5;
        const float* W = p.ada_w + ((size_t)l * 2048 + ksl * 128) * 12288 + cb * 128 + cg4 * 4;
        f32x4 a0 = {0.f, 0.f, 0.f, 0.f}, a1 = a0, a2 = a0;
#pragma unroll 8
        for (int k = 0; k < 128; ++k) { const f32x4 w = *(const f32x4*)(W + (size_t)k * 12288);
            a0 += sl[ksl * 128 + k] * w; a1 += sl[2048 + ksl * 128 + k] * w; a2 += sl[4096 + ksl * 128 + k] * w; }
        *(LAS f32x4*)(red + (ksl * 3 + 0) * 128 + cg4 * 4) = a0; *(LAS f32x4*)(red + (ksl * 3 + 1) * 128 + cg4 * 4) = a1; *(LAS f32x4*)(red + (ksl * 3 + 2) * 128 + cg4 * 4) = a2;
        __syncthreads();
        if (tid < 384) { const int r = tid >> 7, cc = tid & 127; float s = 0.f;
#pragma unroll
            for (int ks = 0; ks < 16; ++ks) s += red[(ks * 3 + r) * 128 + cc];
            MOD[(l * 3 + r) * 12288 + cb * 128 + cc] = s + p.ada_b[l * 12288 + cb * 128 + cc]; }
        __syncthreads();
    }
}

__device__ void phase_convert(const Params& p, int l, LAS unsigned char* lds, int t0, int t1, int w, int nw) {
    LAS float* tile = (LAS float*)lds;
    const int tid = otid();
    for (int T = t0 + w; T < t1; T += nw) {
        const float* src; bf16_t* dst; int K, Nsrc, t = T;
        if (t < 3328) { src = p.w_in + (size_t)l * 2048 * INC; K = 2048; Nsrc = INC; dst = (bf16_t*)(p.ws + OFF_WIN); }
        else if ((t -= 3328) < 4096) { const int i = t >> 10; t &= 1023; src = p.gate_w + (size_t)(l * 4 + i) * 2048 * 2048; K = 2048; Nsrc = 2048; dst = (bf16_t*)(p.ws + OFF_WGT) + (size_t)i * 2048 * 2048; }
        else if ((t -= 4096) < 1024) { const int i = t >> 8; t &= 255; src = p.br_w + (size_t)(l * 4 + i) * 512 * 2048; K = 512; Nsrc = 2048; dst = (bf16_t*)(p.ws + OFF_WBR) + (size_t)i * 2048 * 512; }
        else if ((t -= 1024) < 1024) { src = p.out_w + (size_t)l * 2048 * 2048; K = 2048; Nsrc = 2048; dst = (bf16_t*)(p.ws + OFF_WOUT); }
        else if ((t -= 1024) < 4096) { src = p.ffn_w1 + (size_t)l * 2048 * 8192; K = 2048; Nsrc = 8192; dst = (bf16_t*)(p.ws + OFF_W1); }
        else { t -= 4096; src = p.ffn_w2 + (size_t)l * 8192 * 2048; K = 8192; Nsrc = 2048; dst = (bf16_t*)(p.ws + OFF_W2); }
        const int ntk = K >> 6, tk = t % ntk, tn = t / ntk;
#pragma unroll
        for (int i = 0; i < 8; ++i) { const int e = tid + 512 * i, kk = e >> 6, nn = e & 63, n = tn * 64 + nn;
            tile[kk * 65 + nn] = (n < Nsrc) ? src[(size_t)(tk * 64 + kk) * Nsrc + n] : 0.f; }
        __syncthreads();
        { const int nn = tid >> 3, k8 = (tid & 7) * 8; float f[8];
#pragma unroll
          for (int j = 0; j < 8; ++j) f[j] = tile[(k8 + j) * 65 + nn];
          *(u32x4*)(dst + (size_t)(tn * 64 + nn) * K + tk * 64 + k8) = pack8(f); }
        __syncthreads();
    }
}

__device__ void build_wx1(const Params& p, int l) {
    bf16_t* WX = (bf16_t*)(p.ws + OFF_WX1);
    for (int idx = blockIdx.x * 512 + otid(); idx < 2560 * 384; idx += gridDim.x * 512) {
        const int n = idx / 384, k = idx - n * 384; float v = 0.f;
        if (n < 1024) { const int z = n >> 9, c = n & 511, kk = k - z * 64; if (kk >= 0 && kk < 64) v = p.rw_w_up[((size_t)(l * 2 + z) * 64 + kk) * 512 + c]; }
        else if (n < 2048) { const int z = (n - 1024) >> 9, c = n & 511, kk = k - 128 - z * 64; if (kk >= 0 && kk < 64) v = p.rw_a_up[((size_t)(l * 2 + z) * 64 + kk) * 512 + c]; }
        else { const int c = n - 2048, kk = k - 256; if (kk >= 0) v = p.rw_g_up[((size_t)l * 128 + kk) * 512 + c]; }
        WX[idx] = f2bf(v);
    }
}

__device__ void build_wx2(const Params& p, int l) {
    bf16_t* WX = (bf16_t*)(p.ws + OFF_WX2);
    for (int idx = blockIdx.x * 512 + otid(); idx < 2048 * 512; idx += gridDim.x * 512) {
        const int n = idx >> 9, k = idx & 511, gz = n >> 9, z = gz & 1, ch = n & 511, nb = ch >> 6, j = ch & 63, kk = k - nb * 64; float v = 0.f;
        if (kk >= 0 && kk < 64) { const size_t wi = (((size_t)(l * 2 + z) * 8 + nb) * 64 + kk) * 64 + j; v = (gz >> 1) ? p.lru_w_x[wi] : p.lru_w_a[wi]; }
        WX[idx] = f2bf(v);
    }
}
__device__ void build_xc(const Params& p, int l) {
    const bf16_t* U = (const bf16_t*)(p.ws + OFF_U); bf16_t* XC = (bf16_t*)(p.ws + OFF_XC);
    for (int idx = blockIdx.x * 512 + otid(); idx < MT * 64; idx += gridDim.x * 512) {
        const int m = idx >> 6, c8 = (idx & 63) * 8;
        const bool isctx = m >= ML; int b, L, pcur;
        if (!isctx) { b = m >> 13; const int t = m & 8191; pcur = (t & 63) * 128 + (t >> 6); L = SEQ; } else { const int mm = m - ML; b = mm >> 8; pcur = mm & 255; L = CTX; }
        float acc[8];
        { const f32x4 c0 = *(const f32x4*)(p.lru_conv_b + l * 512 + c8), c1 = *(const f32x4*)(p.lru_conv_b + l * 512 + c8 + 4);
          acc[0] = c0.x; acc[1] = c0.y; acc[2] = c0.z; acc[3] = c0.w; acc[4] = c1.x; acc[5] = c1.y; acc[6] = c1.z; acc[7] = c1.w; }
#pragma unroll
        for (int jt = 0; jt < 4; ++jt) { const int pp = pcur + jt - 2;
            if (pp >= 0 && pp < L) { const int row = isctx ? (ML + b * CTX + pp) : (b * SEQ + ((pp & 127) * 64 + (pp >> 7)));
                float x[8]; unpack8(*(const u32x4*)(U + (size_t)row * INP + C_LRU_X + c8), x);
                const f32x4 w0 = *(const f32x4*)(p.lru_conv_w + (l * 4 + jt) * 512 + c8), w1 = *(const f32x4*)(p.lru_conv_w + (l * 4 + jt) * 512 + c8 + 4);
                acc[0] += w0.x * x[0]; acc[1] += w0.y * x[1]; acc[2] += w0.z * x[2]; acc[3] += w0.w * x[3]; acc[4] += w1.x * x[4]; acc[5] += w1.y * x[5]; acc[6] += w1.z * x[6]; acc[7] += w1.w * x[7]; } }
        *(u32x4*)(XC + (size_t)m * 512 + c8) = pack8(acc);
    }
}
__device__ void build_kk_la(const Params& p, int l) {
    const bf16_t* U = (const bf16_t*)(p.ws + OFF_U); bf16_t* NKK = (bf16_t*)(p.ws + OFF_NKK); bf16_t* LA = (bf16_t*)(p.ws + OFF_LA);
    for (int idx = blockIdx.x * 512 + otid(); idx < MT * 64; idx += gridDim.x * 512) {
        const int m = idx >> 6, q = idx & 63, c8 = q * 8;
        { float k[8]; unpack8(*(const u32x4*)(U + (size_t)m * INP + C_RW_K + c8), k);
          const f32x4 w0 = *(const f32x4*)(p.rw_k_k + l * 512 + c8), w1 = *(const f32x4*)(p.rw_k_k + l * 512 + c8 + 4);
          k[0] *= w0.x; k[1] *= w0.y; k[2] *= w0.z; k[3] *= w0.w; k[4] *= w1.x; k[5] *= w1.y; k[6] *= w1.z; k[7] *= w1.w;
          float ss = 0.f;
#pragma unroll
          for (int j = 0; j < 8; ++j) ss += k[j] * k[j];
          ss = red8(ss);
          const float inv = -1.0f / fmaxf(sqrtf(ss), 1e-12f);
#pragma unroll
          for (int j = 0; j < 8; ++j) k[j] *= inv;
          *(u32x4*)(NKK + (size_t)m * 512 + c8) = pack8(k); }
        { const int z = q >> 5, g8 = (q & 31) * 8;
          float wd[16]; { float t0[8], t1[8]; unpack8(*(const u32x4*)(U + (size_t)m * INP + C_GLA_W + z * 16), t0); unpack8(*(const u32x4*)(U + (size_t)m * INP + C_GLA_W + z * 16 + 8), t1);
#pragma unroll
            for (int j = 0; j < 8; ++j) { wd[j] = t0[j]; wd[8 + j] = t1[j]; } }
          float d[8];
          { const f32x4 b0 = *(const f32x4*)(p.gla_w0 + (l * 2 + z) * 256 + g8), b1 = *(const f32x4*)(p.gla_w0 + (l * 2 + z) * 256 + g8 + 4);
            d[0] = b0.x; d[1] = b0.y; d[2] = b0.z; d[3] = b0.w; d[4] = b1.x; d[5] = b1.y; d[6] = b1.z; d[7] = b1.w; }
#pragma unroll
          for (int r = 0; r < 16; ++r) { const float* wp = p.gla_w_up + ((size_t)(l * 2 + z) * 16 + r) * 256 + g8; const f32x4 u0 = *(const f32x4*)wp, u1 = *(const f32x4*)(wp + 4);
              d[0] += wd[r] * u0.x; d[1] += wd[r] * u0.y; d[2] += wd[r] * u0.z; d[3] += wd[r] * u0.w; d[4] += wd[r] * u1.x; d[5] += wd[r] * u1.y; d[6] += wd[r] * u1.z; d[7] += wd[r] * u1.w; }
#pragma unroll
          for (int j = 0; j < 8; ++j) d[j] = log_sigm(d[j]) * (1.0f / 16.0f);
          *(u32x4*)(LA + ((size_t)z * MT + m) * 256 + g8) = pack8(d); }
    }
}
__device__ void build_ax1(const Params& p) {
    const bf16_t* U = (const bf16_t*)(p.ws + OFF_U); bf16_t* AX = (bf16_t*)(p.ws + OFF_AX1);
    for (int idx = blockIdx.x * 512 + otid(); idx < MT * 48; idx += gridDim.x * 512) {
        const int m = idx / 48, q = idx - m * 48;
        float f[8]; unpack8(*(const u32x4*)(U + (size_t)m * INP + C_RW_W + q * 8), f);
        if (q < 16) {
#pragma unroll
            for (int j = 0; j < 8; ++j) f[j] = tanh_(f[j]); }
        else if (q >= 32) {
#pragma unroll
            for (int j = 0; j < 8; ++j) f[j] = sigm(f[j]); }
        *(u32x4*)(AX + (size_t)m * 384 + q * 8) = pack8(f);
    }
}

__device__ void phase_norm(const float* srcL, const float* srcC, const float* nw, const float* modl, int shoff, int scoff, bf16_t* dst, int M,
                           const float* part = nullptr, int nsplit = 0, const float* pgate = nullptr, float* wb = nullptr) {
    const int tid = otid(), wid = tid >> 6, lane = tid & 63;
    for (int m = blockIdx.x * 8 + wid; m < M; m += gridDim.x * 8) {
        const float* xr = (m < ML) ? srcL + (size_t)m * 2048 : srcC + (size_t)(m - ML) * 2048;
        const float* mr = modl + ((m < ML) ? (m >> 13) : 2) * 12288;
        f32x4 v[8]; float ss = 0.f;
#pragma unroll
        for (int j = 0; j < 8; ++j) v[j] = *(const f32x4*)(xr + j * 256 + lane * 4);
        if (nsplit > 0 && m >= ML) {
#pragma unroll
            for (int j = 0; j < 8; ++j) { const int col = j * 256 + lane * 4; f32x4 a = {0.f, 0.f, 0.f, 0.f};
                for (int sidx = 0; sidx < nsplit; ++sidx) a += *(const f32x4*)(part + ((size_t)sidx * MC + (m - ML)) * 2048 + col);
                v[j] += *(const f32x4*)(pgate + col) * a;
                if (wb) *(f32x4*)(wb + (size_t)m * 2048 + col) = v[j]; }
        }
#pragma unroll
        for (int j = 0; j < 8; ++j) ss += v[j].x * v[j].x + v[j].y * v[j].y + v[j].z * v[j].z + v[j].w * v[j].w;
        ss = wave_sum(ss);
        const float rs = rsqrtf(ss * (1.0f / 2048.0f) + EPS);
#pragma unroll
        for (int j = 0; j < 8; ++j) { const int col = j * 256 + lane * 4;
            const f32x4 w = *(const f32x4*)(nw + col), sh = *(const f32x4*)(mr + shoff + col), sc = *(const f32x4*)(mr + scoff + col);
            const f32x4 y = (v[j] * rs * w) * (1.0f + sc) + sh;
            u32x2 o; o.x = cvt_pk_bf16(y.x, y.y); o.y = cvt_pk_bf16(y.z, y.w);
            *(u32x2*)(dst + (size_t)m * 2048 + col) = o; }
    }
}
__device__ void phase_final_norm(const float* src, const float* nw, float* out) {
    const int tid = otid(), wid = tid >> 6, lane = tid & 63;
    for (int m = blockIdx.x * 8 + wid; m < ML; m += gridDim.x * 8) {
        const float* xr = src + (size_t)m * 2048;
        f32x4 v[8]; float ss = 0.f;
#pragma unroll
        for (int j = 0; j < 8; ++j) { v[j] = *(const f32x4*)(xr + j * 256 + lane * 4); ss += v[j].x * v[j].x + v[j].y * v[j].y + v[j].z * v[j].z + v[j].w * v[j].w; }
        ss = wave_sum(ss);
        const float rs = rsqrtf(ss * (1.0f / 2048.0f) + EPS);
#pragma unroll
        for (int j = 0; j < 8; ++j) { const int col = j * 256 + lane * 4; const f32x4 w = *(const f32x4*)(nw + col);
            *(f32x4*)(out + (size_t)m * 2048 + col) = v[j] * rs * w; }
    }
}

constexpr int TOKT = 66;
__device__ __forceinline__ void phase_prep(const Params& p, int l, LAS unsigned char* lds, int parts) {
    const int tid = otid(), lane = tid & 63;
    const bf16_t* U = (const bf16_t*)(p.ws + OFF_U);
    bf16_t* LW = (bf16_t*)(p.ws + OFF_LW); bf16_t* AA = (bf16_t*)(p.ws + OFF_AA); bf16_t* NKK = (bf16_t*)(p.ws + OFF_NKK); bf16_t* LA = (bf16_t*)(p.ws + OFF_LA);
    if (parts & 1) {
        LAS float* tw = (LAS float*)lds;
        LAS float* ad = (LAS float*)(lds + TOKT * 128 * 4);
        LAS float* gw = (LAS float*)(lds + 2 * TOKT * 128 * 4);
        for (int tile = blockIdx.x; tile < MT / TOKT; tile += gridDim.x) {
            const int m0 = tile * TOKT;
            { const int tid = otid();
            for (int e = tid; e < TOKT * 32; e += 512) { const int tok = e >> 5, jj = e & 31; gw[e] = bf2f(U[(size_t)(m0 + tok) * INP + C_GLA_W + jj]); } }
            __syncthreads();
            { const int c = otid(); const float kkw = p.rw_k_k[l * 512 + c];
              _Pragma("unroll 1") for (int tok = 0; tok < TOKT; ++tok) { const float val = bf2f(U[(size_t)(m0 + tok) * INP + C_RW_K + c]) * kkw;
                  const float ss = wave_sum(val * val); NKK[(size_t)(m0 + tok) * 512 + c] = f2bf(-val / fmaxf(sqrtf(ss), 1e-12f)); } }
            { const int tid = otid(); const int z = tid >> 8, cc = tid & 255; float gcol[16];
              const float* gwb = p.gla_w_up + (size_t)l * 2 * 16 * 256; asm volatile("" : "+s"(gwb));
#pragma unroll
              for (int j = 0; j < 16; ++j) gcol[j] = gwb[(unsigned)((z * 16 + j) * 256 + cc)];
              const float w0 = p.gla_w0[(l * 2 + z) * 256 + cc];
              _Pragma("unroll 1") for (int tok = 0; tok < TOKT; ++tok) { float d = w0;
#pragma unroll
                  for (int j = 0; j < 16; ++j) d += gw[tok * 32 + z * 16 + j] * gcol[j];
                  LA[((size_t)z * MT + m0 + tok) * 256 + cc] = f2bf(log_sigm(d) * (1.0f / 16.0f)); } }
            __syncthreads();
        }
    }
    if (parts & 2) {
        const bf16_t* GATES = (const bf16_t*)(p.ws + OFF_GATES); const bf16_t* XC = (const bf16_t*)(p.ws + OFF_XC);
        bf16_t* LACUM = (bf16_t*)(p.ws + OFF_LACUM); bf16_t* LHLOC = (bf16_t*)(p.ws + OFF_LHLOC);
        float* APROD = (float*)(p.ws + OFF_APROD); float* HEND = (float*)(p.ws + OFF_HEND);
        for (int item = blockIdx.x; item < 2 * 2 * NCH; item += gridDim.x) {
            const int ch = otid();
            const int z = item / (2 * NCH), b = (item / NCH) & 1, cidx = item % NCH;
            const bool isctx = cidx < 8; const int p0 = (isctx ? cidx : cidx - 8) * 32;
            auto rowof = [&](int pp) -> int { return isctx ? (ML + b * CTX + pp) : (b * SEQ + ((pp & 127) * 64 + (pp >> 7))); };
            const float sp = softplus_(-p.lru_lambda[(l * 2 + z) * 512 + ch]);
            float h = 0.f, Ac = 1.f;
#pragma unroll 1
            for (int half = 0; half < 2; ++half) {
                bf16_t rgv[16], igv[16], xcv[16]; int rows[16];
#pragma unroll
                for (int i = 0; i < 16; ++i) { const int ii = half * 16 + i, pp = z ? 31 - ii : ii; const int m = rowof(p0 + pp); rows[i] = m;
                    rgv[i] = GATES[((size_t)z * MT + m) * 512 + ch]; igv[i] = GATES[((size_t)(2 + z) * MT + m) * 512 + ch]; xcv[i] = XC[(size_t)m * 512 + ch]; }
#pragma unroll
                for (int i = 0; i < 16; ++i) { const float log_a = -8.0f * bf2f(rgv[i]) * sp, a = __expf(log_a);
                    const float bt = sqrt_g(fmaxf(1.0f - a * a, 0.0f)) * bf2f(igv[i]) * bf2f(xcv[i]);
                    h = a * h + bt; Ac *= a;
                    const size_t o = ((size_t)z * MT + rows[i]) * 512 + ch;
                    LACUM[o] = f2bf(Ac); LHLOC[o] = f2bf(h); }
            }
            const size_t so = ((size_t)(z * 2 + b) * NCH + cidx) * 512 + ch;
            APROD[so] = Ac; HEND[so] = h;
        }
    }
}

template <int MIX> struct ScanCfg;
template <> struct ScanCfg<0> { static constexpr int STEPF = 352, EPL = 8, NRAW = 22; };
template <> struct ScanCfg<1> { static constexpr int STEPF = 224, EPL = 8, NRAW = 14; };
template <> struct ScanCfg<2> { static constexpr int STEPF = 292, EPL = 16, NRAW = 19; };
template <> struct ScanCfg<3> { static constexpr int STEPF = 292, EPL = 16, NRAW = 19; };

template <int MIX>
__device__ void scan_role(const Params& p, const int l, LAS unsigned char* lds, const int chain, const int sub) {
    constexpr int STEPF = ScanCfg<(MIX)>::STEPF, EPL = ScanCfg<(MIX)>::EPL, NRAW = ScanCfg<(MIX)>::NRAW, BUFB = 45056;
    const int tid = otid(), wid = tid >> 6, lane = tid & 63, rs = lane >> 4, ks = lane & 15, row = wid * 4 + rs;
    const bf16_t* U = (const bf16_t*)(p.ws + OFF_U);
    const bf16_t* LW = (const bf16_t*)(p.ws + OFF_LW); const bf16_t* AA = (const bf16_t*)(p.ws + OFF_AA); const bf16_t* NKK = (const bf16_t*)(p.ws + OFF_NKK); const bf16_t* LA = (const bf16_t*)(p.ws + OFF_LA);
    int z, b, h;
    if (MIX == 0) { z = chain >> 4; b = (chain >> 3) & 1; h = chain & 7; } else { z = chain >> 3; b = (chain >> 2) & 1; h = chain & 3; }
    LAS float* ylds = (LAS float*)(lds + 2 * BUFB);
    auto tokrow = [&](int sg) -> int { if (sg < CTX) { const int t = z ? (CTX - 1 - sg) : sg; return ML + b * CTX + t; } const int s2 = sg - CTX; const int t = z ? (SEQ - 1 - s2) : s2; return b * SEQ + t; };
    float fb = 0.f, ib = 0.f;
    if (MIX >= 2) { fb = p.ml_f_b[(l * 2 + z) * 4 + h]; ib = p.ml_i_b[(l * 2 + z) * 4 + h]; }
    const int stid = tid & 255, sq = stid & 15;
    f32x4 ka4 = {0.f, 0.f, 0.f, 0.f};
    if (MIX == 0) ka4 = *(const f32x4*)(p.rw_k_a + l * 512 + h * 64 + sq * 4);
    struct Raw { u32x4 q0, q1; u32x2 d0, d1, d2, d3, d4; unsigned v; };
    Raw rwA, rwB; bf16_t rsc = 0;
    rwA.q0 = (u32x4){0u, 0u, 0u, 0u}; rwA.q1 = rwA.q0; rwA.d0 = (u32x2){0u, 0u}; rwA.d1 = rwA.d0; rwA.d2 = rwA.d0; rwA.d3 = rwA.d0; rwA.d4 = rwA.d0; rwA.v = 0u; rwB = rwA;
    auto load_raw1 = [&](int blk, int i, Raw& r) {
        const int sst = (stid >> 4) + 16 * i;
        const size_t m = (size_t)tokrow(blk * 32 + sst);
        if (MIX == 0) { const int cc = h * 64 + sq * 4;
            r.d0 = *(const u32x2*)(LW + ((size_t)z * MT + m) * 512 + cc); r.d1 = *(const u32x2*)(NKK + m * 512 + cc); r.d2 = *(const u32x2*)(AA + ((size_t)z * MT + m) * 512 + cc);
            r.d3 = *(const u32x2*)(U + m * INP + C_RW_K + cc); r.d4 = *(const u32x2*)(U + m * INP + C_RW_R + cc);
            r.v = *(const unsigned*)(U + m * INP + C_RW_V + h * 64 + sub * 32 + sq * 2);
        } else if (MIX == 1) { const int cc = h * 64 + sq * 4;
            r.d0 = *(const u32x2*)(LA + ((size_t)z * MT + m) * 256 + cc); r.d1 = *(const u32x2*)(U + m * INP + C_GLA_K + cc); r.d2 = *(const u32x2*)(U + m * INP + C_GLA_Q + cc);
            r.v = *(const unsigned*)(U + m * INP + C_GLA_V + h * 128 + sub * 32 + sq * 2);
        } else { const int cc = h * 128 + sq * 8;
            r.q0 = *(const u32x4*)(U + m * INP + C_ML_K + cc); r.q1 = *(const u32x4*)(U + m * INP + C_ML_Q + cc);
            r.v = *(const unsigned*)(U + m * INP + C_ML_V + h * 128 + sub * 32 + sq * 2);
        }
    };
    auto load_raw = [&](int blk) {
        load_raw1(blk, 0, rwA); load_raw1(blk, 1, rwB);
        if (MIX >= 2 && stid < 64) { const int st = stid & 31, which = (stid >> 5) & 1; const size_t m2 = (size_t)tokrow(blk * 32 + st); rsc = U[m2 * INP + (which ? C_ML_I : C_ML_F) + z * 4 + h]; }
    };
    auto store_img1 = [&](int bufsel, int i, const Raw& r) {
        const int sst = (stid >> 4) + 16 * i;
        LAS float* sp = (LAS float*)(lds + bufsel * BUFB) + sst * STEPF;
        const f32x2 vv = {__uint_as_float(r.v << 16), __uint_as_float(r.v & 0xffff0000u)};
        if (MIX == 0) {
            float lw[4], nk[4], a[4], k[4], rr[4]; unpack4(r.d0, lw); unpack4(r.d1, nk); unpack4(r.d2, a); unpack4(r.d3, k); unpack4(r.d4, rr);
            *(LAS f32x4*)(sp + sq * 4) = (f32x4){__expf(lw[0]), __expf(lw[1]), __expf(lw[2]), __expf(lw[3])};
            *(LAS f32x4*)(sp + 64 + sq * 4) = (f32x4){nk[0], nk[1], nk[2], nk[3]};
            *(LAS f32x4*)(sp + 128 + sq * 4) = (f32x4){-nk[0] * a[0], -nk[1] * a[1], -nk[2] * a[2], -nk[3] * a[3]};
            *(LAS f32x4*)(sp + 192 + sq * 4) = (f32x4){k[0] * (1.0f + (a[0] - 1.0f) * ka4.x), k[1] * (1.0f + (a[1] - 1.0f) * ka4.y), k[2] * (1.0f + (a[2] - 1.0f) * ka4.z), k[3] * (1.0f + (a[3] - 1.0f) * ka4.w)};
            *(LAS f32x4*)(sp + 256 + sq * 4) = (f32x4){rr[0], rr[1], rr[2], rr[3]};
            *(LAS f32x2*)(sp + 320 + sq * 2) = vv;
        } else if (MIX == 1) {
            float la[4], k[4], q[4]; unpack4(r.d0, la); unpack4(r.d1, k); unpack4(r.d2, q);
            *(LAS f32x4*)(sp + sq * 4) = (f32x4){__expf(la[0]), __expf(la[1]), __expf(la[2]), __expf(la[3])};
            *(LAS f32x4*)(sp + 64 + sq * 4) = (f32x4){k[0], k[1], k[2], k[3]};
            *(LAS f32x4*)(sp + 128 + sq * 4) = (f32x4){q[0] * 0.125f, q[1] * 0.125f, q[2] * 0.125f, q[3] * 0.125f};
            *(LAS f32x2*)(sp + 192 + sq * 2) = vv;
        } else {
            float k[8], q[8]; unpack8(r.q0, k); unpack8(r.q1, q);
            const float ksc = 0.08838834764831845f;
            *(LAS f32x4*)(sp + sq * 8) = (f32x4){k[0] * ksc, k[1] * ksc, k[2] * ksc, k[3] * ksc}; *(LAS f32x4*)(sp + sq * 8 + 4) = (f32x4){k[4] * ksc, k[5] * ksc, k[6] * ksc, k[7] * ksc};
            *(LAS f32x4*)(sp + 128 + sq * 8) = (f32x4){q[0], q[1], q[2], q[3]}; *(LAS f32x4*)(sp + 128 + sq * 8 + 4) = (f32x4){q[4], q[5], q[6], q[7]};
            *(LAS f32x2*)(sp + 256 + sq * 2) = (MIX == 3) ? (f32x2){1.0f, 1.0f} : vv;
        }
    };
    auto store_img = [&](int bufsel) {
        store_img1(bufsel, 0, rwA); store_img1(bufsel, 1, rwB);
        if (MIX >= 2 && stid < 64) { const int st = stid & 31, which = stid >> 5; const float xv = bf2f(rsc); LAS float* img = (LAS float*)(lds + bufsel * BUFB);
            if (which == 0) img[st * STEPF + 288] = sigm(xv + fb); else img[st * STEPF + 289] = __expf(xv + ib); }
    };
    f32x2 S2[EPL / 2];
#pragma unroll
    for (int j = 0; j < EPL / 2; ++j) S2[j] = (f32x2){0.f, 0.f};
    bf16_t* Yout = (bf16_t*)(p.ws + (MIX == 0 ? OFF_YRW : (MIX == 1 ? OFF_YGL : OFF_YML)));
    const int cbase = (MIX == 0) ? (h * 64 + sub * 32) : (h * 128 + sub * 32);
    constexpr int NV = EPL / 4;
    const int crs = lane >> 3, cks = lane & 7, crow = wid * 8 + crs;
    struct In { f32x4 a[NV], b[NV], c[NV], d[NV], e[NV]; float v, f, iw; };
    auto load_in = [&](const LAS float* sp) -> In {
        In r;
#pragma unroll
        for (int j = 0; j < NV; ++j) { const int o = (j * 8 + cks) * 4;
            if (MIX == 0) { r.a[j] = *(const LAS f32x4*)(sp + o); r.b[j] = *(const LAS f32x4*)(sp + 64 + o); r.c[j] = *(const LAS f32x4*)(sp + 128 + o); r.d[j] = *(const LAS f32x4*)(sp + 192 + o); r.e[j] = *(const LAS f32x4*)(sp + 256 + o); }
            else if (MIX == 1) { r.a[j] = *(const LAS f32x4*)(sp + o); r.b[j] = *(const LAS f32x4*)(sp + 64 + o); r.c[j] = *(const LAS f32x4*)(sp + 128 + o); r.d[j] = r.a[j]; r.e[j] = r.a[j]; }
            else { r.a[j] = *(const LAS f32x4*)(sp + o); r.c[j] = *(const LAS f32x4*)(sp + 128 + o); r.b[j] = r.a[j]; r.d[j] = r.a[j]; r.e[j] = r.a[j]; } }
        if (MIX == 0) { r.v = sp[320 + crow]; r.f = 0.f; r.iw = 0.f; }
        else if (MIX == 1) { r.v = sp[192 + crow]; r.f = 0.f; r.iw = 0.f; }
        else { r.v = sp[256 + crow]; const f32x2 fi = *(const LAS f32x2*)(sp + 288); r.f = fi.x; r.iw = fi.y; }
        return r;
    };
#define LO2(V_) ((f32x2){(V_)[0], (V_)[1]})
#define HI2(V_) ((f32x2){(V_)[2], (V_)[3]})

    float* DENp = (float*)(p.ws + OFF_DEN);
    auto write_out = [&](int blk) {
        const LAS float* yl = ylds + (blk & 1) * 1024;
        if (MIX < 3) {
#pragma unroll
            for (int i = 0; i < 2; ++i) { const int st = (stid >> 4) + 16 * i, rp = stid & 15; const size_t m = (size_t)tokrow(blk * 32 + st);
                *(unsigned*)(Yout + ((size_t)z * MT + m) * 512 + cbase + 2 * rp) = cvt_pk_bf16(yl[st * 32 + 2 * rp], yl[st * 32 + 2 * rp + 1]); }
        } else if (stid < 32) { const size_t m = (size_t)tokrow(blk * 32 + stid); DENp[((size_t)z * MT + m) * 4 + h] = yl[stid * 32]; }
    };
    if (wid >= 4) { load_raw(0); store_img(0); load_raw(1); }
    __syncthreads();
    for (int blk = 0; blk < NCH; ++blk) {
        if (wid >= 4) {
            if (blk + 1 < NCH) store_img((blk + 1) & 1);
            if (blk >= 1) write_out(blk - 1);
            if (blk + 2 < NCH) load_raw(blk + 2);
        } else {
        LAS float* ylw = ylds + (blk & 1) * 1024;
        const LAS float* img = (const LAS float*)(lds + (blk & 1) * BUFB);
        In cur = load_in(img);
#pragma unroll 1
        for (int g = 0; g < 4; ++g) {
        float pd[8];
#pragma unroll
        for (int s8 = 0; s8 < 8; ++s8) {
            const int st = g * 8 + s8;
            const In nxt = load_in(img + ((st + 1 < 32) ? (st + 1) : 31) * STEPF);
            if (MIX == 0) {
                f32x2 da = S2[0] * LO2(cur.b[0]), db = S2[1] * HI2(cur.b[0]);
                f32x2 t[EPL / 2];
#pragma unroll
                for (int j = 1; j < NV; ++j) { da += S2[2 * j] * LO2(cur.b[j]); db += S2[2 * j + 1] * HI2(cur.b[j]); }
                const f32x2 d0 = da + db;
                float sa = d0.x + d0.y;
#pragma unroll
                for (int j = 0; j < NV; ++j) { t[2 * j] = S2[2 * j] * LO2(cur.a[j]) + LO2(cur.d[j]) * cur.v; t[2 * j + 1] = S2[2 * j + 1] * HI2(cur.a[j]) + HI2(cur.d[j]) * cur.v; }
                sa = red8(sa);
#pragma unroll
                for (int j = 0; j < NV; ++j) { S2[2 * j] = t[2 * j] + LO2(cur.c[j]) * sa; S2[2 * j + 1] = t[2 * j + 1] + HI2(cur.c[j]) * sa; }
                f32x2 ea = S2[0] * LO2(cur.e[0]), eb = S2[1] * HI2(cur.e[0]);
#pragma unroll
                for (int j = 1; j < NV; ++j) { ea += S2[2 * j] * LO2(cur.e[j]); eb += S2[2 * j + 1] * HI2(cur.e[j]); }
                const f32x2 d1 = ea + eb;
                pd[s8] = d1.x + d1.y;
            } else if (MIX == 1) {
#pragma unroll
                for (int j = 0; j < NV; ++j) { S2[2 * j] = S2[2 * j] * LO2(cur.a[j]) + LO2(cur.b[j]) * cur.v; S2[2 * j + 1] = S2[2 * j + 1] * HI2(cur.a[j]) + HI2(cur.b[j]) * cur.v; }
                f32x2 ea = S2[0] * LO2(cur.c[0]), eb = S2[1] * HI2(cur.c[0]);
#pragma unroll
                for (int j = 1; j < NV; ++j) { ea += S2[2 * j] * LO2(cur.c[j]); eb += S2[2 * j + 1] * HI2(cur.c[j]); }
                const f32x2 d1 = ea + eb;
                pd[s8] = d1.x + d1.y;
            } else {
                const float iv = cur.iw * cur.v, f = cur.f;
#pragma unroll
                for (int j = 0; j < NV; ++j) { S2[2 * j] = S2[2 * j] * f + LO2(cur.a[j]) * iv; S2[2 * j + 1] = S2[2 * j + 1] * f + HI2(cur.a[j]) * iv; }
                f32x2 ea = S2[0] * LO2(cur.c[0]), eb = S2[1] * HI2(cur.c[0]);
#pragma unroll
                for (int j = 1; j < NV; ++j) { ea += S2[2 * j] * LO2(cur.c[j]); eb += S2[2 * j + 1] * HI2(cur.c[j]); }
                const f32x2 d1 = ea + eb;
                pd[s8] = d1.x + d1.y;
            }
            cur = nxt;
        }
#pragma unroll
        for (int s8 = 0; s8 < 8; ++s8) pd[s8] += dppmov<0xB1>(pd[s8]);
#pragma unroll
        for (int s8 = 0; s8 < 8; ++s8) pd[s8] += dppmov<0x4E>(pd[s8]);
#pragma unroll
        for (int s8 = 0; s8 < 8; ++s8) pd[s8] += dppmov<0x141>(pd[s8]);
        float yk = pd[0];
#pragma unroll
        for (int s8 = 1; s8 < 8; ++s8) yk = (cks == s8) ? pd[s8] : yk;
        ylw[(g * 8 + cks) * 32 + crow] = yk;
        }
        }
        __syncthreads();
    }
    if (wid >= 4) write_out(NCH - 1);
}

__device__ void lru_carry_role(const Params& p, int zb) {
    const float* APROD = (const float*)(p.ws + OFF_APROD); const float* HEND = (const float*)(p.ws + OFF_HEND); float* CARRY = (float*)(p.ws + OFF_CARRY);
    const int z = zb >> 1, ch = otid(); const size_t base = (size_t)zb * NCH * 512 + ch;
    float h = 0.f;
    for (int g8 = 0; g8 < NCH / 8; ++g8) {
        float a[8], e[8]; int ci[8];
#pragma unroll
        for (int j = 0; j < 8; ++j) { const int i = g8 * 8 + j; ci[j] = (i < 8) ? (z ? 7 - i : i) : (z ? (NCH - 1) - (i - 8) : i); a[j] = APROD[base + (size_t)ci[j] * 512]; e[j] = HEND[base + (size_t)ci[j] * 512]; }
#pragma unroll
        for (int j = 0; j < 8; ++j) { CARRY[base + (size_t)ci[j] * 512] = h; h = a[j] * h + e[j]; }
    }
}

__device__ void phase_scan(const Params& p, int l, LAS unsigned char* lds, int cmask = 31) {
    if (cmask == 31) {
        const int nidle = (int)gridDim.x - 212;
        const int w = nidle > 0 ? (int)blockIdx.x - 212 : (int)blockIdx.x, nw = nidle > 0 ? nidle : (int)gridDim.x;
        if (w >= 0) { phase_convert(p, l, lds, 3328, 17664, w, nw); if (l == 0) phase_convert(p, 1, lds, 0, 3328, w, nw); __syncthreads(); }
    }
    for (int role = blockIdx.x; role < 212; role += gridDim.x) {
        const int cls = role < 64 ? 1 : (role < 128 ? 2 : (role < 192 ? 4 : (role < 208 ? 8 : 16)));
        if (!(cmask & cls)) continue;
        if (role < 64) scan_role<0>(p, l, lds, role >> 1, role & 1);
        else if (role < 128) scan_role<1>(p, l, lds, (role - 64) >> 2, (role - 64) & 3);
        else if (role < 192) scan_role<2>(p, l, lds, (role - 128) >> 2, (role - 128) & 3);
        else if (role < 208) scan_role<3>(p, l, lds, role - 192, 0);
        else lru_carry_role(p, role - 208);
        __syncthreads();
    }
}

__device__ void phase_post(const Params& p, int l, LAS unsigned char* lds) {
    const int tid = otid(), wid = tid >> 6, lane = tid & 63;
    const bf16_t* U = (const bf16_t*)(p.ws + OFF_U);
    const bf16_t* YRW = (const bf16_t*)(p.ws + OFF_YRW); const bf16_t* YGL = (const bf16_t*)(p.ws + OFF_YGL); const bf16_t* YML = (const bf16_t*)(p.ws + OFF_YML);
    const float* DEN = (const float*)(p.ws + OFF_DEN);
    const bf16_t* LACUM = (const bf16_t*)(p.ws + OFF_LACUM); const bf16_t* LHLOC = (const bf16_t*)(p.ws + OFF_LHLOC); const float* CARRY = (const float*)(p.ws + OFF_CARRY);
    bf16_t* YS = (bf16_t*)(p.ws + OFF_YS); const bf16_t* GV = (const bf16_t*)(p.ws + OFF_GV);
    {
        const int c8 = lane * 8;
        float lnw8[8], rk8[8];
        { const f32x4 a0 = *(const f32x4*)(p.rw_ln_w + l * 512 + c8), a1 = *(const f32x4*)(p.rw_ln_w + l * 512 + c8 + 4), b0 = *(const f32x4*)(p.rw_r_k + l * 512 + c8), b1 = *(const f32x4*)(p.rw_r_k + l * 512 + c8 + 4);
          lnw8[0] = a0.x; lnw8[1] = a0.y; lnw8[2] = a0.z; lnw8[3] = a0.w; lnw8[4] = a1.x; lnw8[5] = a1.y; lnw8[6] = a1.z; lnw8[7] = a1.w;
          rk8[0] = b0.x; rk8[1] = b0.y; rk8[2] = b0.z; rk8[3] = b0.w; rk8[4] = b1.x; rk8[5] = b1.y; rk8[6] = b1.z; rk8[7] = b1.w; }
        _Pragma("unroll 1") for (int mi = blockIdx.x * 8 + wid; mi < MT; mi += gridDim.x * 8) { const size_t m = (size_t)mi;
            { float y0[8], y1[8], r[8], k[8], v[8], g[8], oo[8];
              unpack8(*(const u32x4*)(YRW + m * 512 + c8), y0); unpack8(*(const u32x4*)(YRW + ((size_t)MT + m) * 512 + c8), y1);
              unpack8(*(const u32x4*)(U + m * INP + C_RW_R + c8), r); unpack8(*(const u32x4*)(U + m * INP + C_RW_K + c8), k); unpack8(*(const u32x4*)(U + m * INP + C_RW_V + c8), v);
              unpack8(*(const u32x4*)(GV + m * 512 + c8), g);
              float ss = 0.f, bs = 0.f;
#pragma unroll
              for (int j = 0; j < 8; ++j) { y0[j] += y1[j]; ss += y0[j] * y0[j]; bs += r[j] * k[j] * rk8[j]; }
              ss = red8(ss); bs = red8(bs);
              const float rn = rsqrtf(ss * (1.0f / 64.0f) + EPS);
#pragma unroll
              for (int j = 0; j < 8; ++j) oo[j] = (y0[j] * rn * lnw8[j] + bs * v[j]) * g[j];
              *(u32x4*)(YS + m * 2048 + c8) = pack8(oo); }
            int b, cidx;
            if (m < (size_t)ML) { b = (int)(m >> 13); const int t = (int)(m & 8191); const int pp = (t & 63) * 128 + (t >> 6); cidx = 8 + (pp >> 5); }
            else { const int mm = (int)m - ML; b = mm >> 8; cidx = (mm & 255) >> 5; }
            float o[8];
            { float hs[8];
#pragma unroll
              for (int j = 0; j < 8; ++j) hs[j] = 0.f;
#pragma unroll
              for (int z = 0; z < 2; ++z) { float ac[8], hl[8]; unpack8(*(const u32x4*)(LACUM + ((size_t)z * MT + m) * 512 + c8), ac); unpack8(*(const u32x4*)(LHLOC + ((size_t)z * MT + m) * 512 + c8), hl);
                  const float* cp = CARRY + ((size_t)(z * 2 + b) * NCH + cidx) * 512 + c8; const f32x4 c0 = *(const f32x4*)cp, c1 = *(const f32x4*)(cp + 4);
                  hs[0] += ac[0] * c0.x + hl[0]; hs[1] += ac[1] * c0.y + hl[1]; hs[2] += ac[2] * c0.z + hl[2]; hs[3] += ac[3] * c0.w + hl[3];
                  hs[4] += ac[4] * c1.x + hl[4]; hs[5] += ac[5] * c1.y + hl[5]; hs[6] += ac[6] * c1.z + hl[6]; hs[7] += ac[7] * c1.w + hl[7]; }
              float gb[8]; unpack8(*(const u32x4*)(U + m * INP + C_LRU_G + c8), gb);
#pragma unroll
              for (int j = 0; j < 8; ++j) o[j] = hs[j] * gelu_fast(gb[j]);
              *(u32x4*)(YS + m * 2048 + 512 + c8) = pack8(o); }
            { float a0[8], a1[8]; unpack8(*(const u32x4*)(YGL + m * 512 + c8), a0); unpack8(*(const u32x4*)(YGL + ((size_t)MT + m) * 512 + c8), a1);
              float ss = 0.f;
#pragma unroll
              for (int j = 0; j < 8; ++j) { a0[j] += a1[j]; ss += a0[j] * a0[j]; }
              ss = red16(ss);
              const float rn = rsqrtf(ss * (1.0f / 128.0f) + EPS);
              float rg[8]; unpack8(*(const u32x4*)(U + m * INP + C_GLA_R + c8), rg);
              const float* lw = p.gla_ln_w + l * 512 + c8;
#pragma unroll
              for (int j = 0; j < 8; ++j) o[j] = a0[j] * rn * lw[j] * (rg[j] * sigm_fast(rg[j]));
              *(u32x4*)(YS + m * 2048 + 1024 + c8) = pack8(o); }
            { float a0[8], a1[8]; unpack8(*(const u32x4*)(YML + m * 512 + c8), a0); unpack8(*(const u32x4*)(YML + ((size_t)MT + m) * 512 + c8), a1);
              const int hd = lane >> 4; const float d0 = DEN[m * 4 + hd], d1 = DEN[((size_t)MT + m) * 4 + hd];
              const float i0 = rcp_g(fmaxf(fabsf(d0), 1.0f)), i1 = rcp_g(fmaxf(fabsf(d1), 1.0f));
              float ss = 0.f;
#pragma unroll
              for (int j = 0; j < 8; ++j) { a0[j] = a0[j] * i0 + a1[j] * i1; ss += a0[j] * a0[j]; }
              ss = red16(ss);
              const float rn = rsqrtf(ss * (1.0f / 128.0f) + EPS);
              float og[8]; unpack8(*(const u32x4*)(U + m * INP + C_ML_O + c8), og);
              const float* lw = p.ml_ln_w + l * 512 + c8;
#pragma unroll
              for (int j = 0; j < 8; ++j) o[j] = a0[j] * rn * lw[j] * sigm_fast(og[j]);
              *(u32x4*)(YS + m * 2048 + 1536 + c8) = pack8(o); }
        }
    }
}


#define XB_TMO      128
#define XB_XCNT(j)  (256  + 64 * (j))
#define XB_XSUB(j)  (1280 + 64 * (j))
#define XB_XGEN(j)  (2304 + 64 * (j))
#define XB_TOP      3328
#define XB_TOPGEN   3392
#define XCD_BAR_WORDS 3456
#define XB_SPIN_CAP (1u << 22)
__device__ __forceinline__ unsigned xb_ld(unsigned* p)              { return __hip_atomic_load(p, __ATOMIC_RELAXED, __HIP_MEMORY_SCOPE_AGENT); }
__device__ __forceinline__ unsigned xb_add(unsigned* p, unsigned v) { return __hip_atomic_fetch_add(p, v, __ATOMIC_RELAXED, __HIP_MEMORY_SCOPE_AGENT); }
__device__ __forceinline__ unsigned xb_xcc_id() { return (unsigned)__builtin_amdgcn_s_getreg((3 << 11) | 20) & 0xFu; }
#define XB_SPIN(cond, bar) do { unsigned _sp = 0; while (cond) { __builtin_amdgcn_s_sleep(1); \
    if ((++_sp & 255u) == 0u) { if (xb_ld(&(bar)[XB_TMO])) break; if (_sp > XB_SPIN_CAP) { atomicAdd(&(bar)[XB_TMO], 1u); break; } } } } while (0)
struct XcdBarrier { unsigned* bar; unsigned x; volatile LAS unsigned* st; };
__device__ __forceinline__ XcdBarrier xcd_barrier_post(unsigned* bar, volatile LAS unsigned* st) {
    XcdBarrier b; b.bar = bar; b.x = xb_xcc_id(); b.st = st;
    if (threadIdx.x == 0) (void)xb_add(&bar[XB_XCNT(b.x)], 1u);
    return b;
}
__device__ __forceinline__ void xcd_barrier_complete(unsigned* bar, unsigned x, unsigned& nloc, unsigned& nx) {
    const unsigned G = gridDim.x * gridDim.y * gridDim.z;
    unsigned sum, cnt, mine, sp = 0u;
    for (;;) {
        sum = 0u; cnt = 0u; mine = 0u;
#pragma unroll
        for (unsigned j = 0; j < 16; ++j) { const unsigned c = xb_ld(&bar[XB_XCNT(j)]); sum += c; cnt += (c > 0u) ? 1u : 0u; mine = (j == x) ? c : mine; }
        if (sum == G) break;
        __builtin_amdgcn_s_sleep(1);
        if ((++sp & 255u) == 0u) { if (xb_ld(&bar[XB_TMO])) break; if (sp > XB_SPIN_CAP) { atomicAdd(&bar[XB_TMO], 1u); break; } }
    }
    nloc = mine > 0u ? mine : 1u; nx = cnt > 0u ? cnt : 1u;
}
__device__ __forceinline__ void xcd_barrier(const XcdBarrier& b, unsigned* bar) {
    asm volatile("s_waitcnt vmcnt(0)" ::: "memory");
    __syncthreads();
    if (threadIdx.x == 0) {
        __builtin_amdgcn_s_waitcnt(0);
        unsigned nloc = b.st[0], nx = b.st[1];
        if (nloc == 0u) { xcd_barrier_complete(bar, b.x, nloc, nx); b.st[0] = nloc; b.st[1] = nx; }
        const unsigned old = xb_add(&bar[XB_XSUB(b.x)], 1u);
        const unsigned gen = old / nloc;
        if (old + 1u == (gen + 1u) * nloc) {
            __builtin_amdgcn_fence(__ATOMIC_RELEASE, "agent");
            asm volatile("s_waitcnt vmcnt(0)" ::: "memory");
            const unsigned og = xb_add(&bar[XB_TOP], 1u);
            const unsigned tg = og / nx;
            if (og + 1u == (tg + 1u) * nx) xb_add(&bar[XB_TOPGEN], 1u);
            else XB_SPIN(xb_ld(&bar[XB_TOPGEN]) == tg, bar);
            __builtin_amdgcn_fence(__ATOMIC_ACQUIRE, "agent");
            xb_add(&bar[XB_XGEN(b.x)], 1u);
            asm volatile("s_waitcnt vmcnt(0)" ::: "memory");
        } else {
            XB_SPIN(xb_ld(&bar[XB_XGEN(b.x)]) == gen, bar);
            __builtin_amdgcn_fence(__ATOMIC_ACQUIRE, "agent");
            asm volatile("s_waitcnt vmcnt(0)" ::: "memory");
        }
    }
    __syncthreads();
}

template <int PH>
__device__ __forceinline__ void do_phase(const Params& p, const int l, LAS unsigned char* lds) {
    const int G = gridDim.x, cb = blockIdx.x;
    unsigned char* ws = p.ws;
    float* MOD = (float*)(ws + OFF_MOD);
    float* XB = (float*)(ws + OFF_XB);
    bf16_t* HX = (bf16_t*)(ws + OFF_HX);
    const float* modl = MOD + l * 3 * 12288;
    const float* srcL = (l == 0) ? p.x : XB;
    const float* srcC = (l == 0) ? p.ctx : XB + (size_t)ML * 2048;
    const int Mx = (l == 0) ? MT : ML;
    if constexpr (PH == 0) { phase_mod(p, lds); __syncthreads(); phase_convert(p, 0, lds, 0, 3328, cb, G); }
    if constexpr (PH == 1) { build_wx1(p, l); build_wx2(p, l);
        phase_norm(srcL, srcC, p.norm_mix_w + l * 2048, modl, 0, 2048, HX, MT, (const float*)(ws + OFF_PREP), (l == 1) ? 16 : 0, MOD + 2 * 12288 + 5 * 2048, nullptr); }
    if constexpr (PH == 2) { pg8::Gemm g{HX, (const bf16_t*)(ws + OFF_WIN), MT, INP, 2048, 2048, 2048}; pg8::Sched S; S.init(MT, INP, G, cb, 1);
        pg8::EpiB16<0, INP> E{(bf16_t*)(ws + OFF_U), nullptr}; pg8::gemm_phase(lds, g, S, E); }
    if constexpr (PH == 13) { build_ax1(p); build_xc(p, l); build_kk_la(p, l); }
    if constexpr (PH == 14) { pg8::Gemm g{(const bf16_t*)(ws + OFF_AX1), (const bf16_t*)(ws + OFF_WX1), MT, 2560, 384, 384, 384}; pg8::Sched S; S.init(MT, 2560, G, cb, 1);
        pg8::EpiRWX E{(bf16_t*)(ws + OFF_LW), (bf16_t*)(ws + OFF_AA), (bf16_t*)(ws + OFF_GV), p.rw_w0 + l * 1024, p.rw_a0 + l * 1024}; pg8::gemm_phase(lds, g, S, E); }
    if constexpr (PH == 15) { pg8::Gemm g{(const bf16_t*)(ws + OFF_XC), (const bf16_t*)(ws + OFF_WX2), MT, 2048, 512, 512, 512}; pg8::Sched S; S.init(MT, 2048, G, cb, 1);
        pg8::EpiGate E{(bf16_t*)(ws + OFF_GATES), p.lru_b_a + l * 1024, p.lru_b_x + l * 1024}; pg8::gemm_phase(lds, g, S, E); }
    if constexpr (PH == 16) phase_prep(p, l, lds, 1);
    if constexpr (PH == 3) phase_prep(p, l, lds, 2);
    if constexpr (PH == 4) phase_scan(p, l, lds);
#ifdef SCAN_PROBE_MASK
    if constexpr (PH == 14) phase_scan(p, l, lds, SCAN_PROBE_MASK);
#endif
    if constexpr (PH == 5) phase_post(p, l, lds);
    if constexpr (PH == 6) { pg8::Gemm g{HX, (const bf16_t*)(ws + OFF_WGT), Mx, 8192, 2048, 2048, 2048}; pg8::Sched S; S.init(Mx, 8192, G, cb, 1);
        pg8::EpiB16<1, 8192> E{(bf16_t*)(ws + OFF_G), p.gate_b + l * 8192}; pg8::gemm_phase(lds, g, S, E); }
    if constexpr (PH == 7) { pg8::Gemm g{(const bf16_t*)(ws + OFF_YS), (const bf16_t*)(ws + OFF_WBR), Mx, 2048, 512, 2048, 512}; pg8::Sched S; S.init(Mx, 2048, G, cb, 4);
        pg8::EpiBr E{(const bf16_t*)(ws + OFF_G), (bf16_t*)(ws + OFF_ACC)}; pg8::gemm_phase(lds, g, S, E); }
    if constexpr (PH == 8) { { pg8::Gemm g{(const bf16_t*)(ws + OFF_ACC), (const bf16_t*)(ws + OFF_WOUT), ML, 2048, 2048, 2048, 2048}; pg8::Sched S; S.init(ML, 2048, G, cb, 1);
          pg8::EpiRes E{srcL, srcC, XB, modl, 2 * 2048}; pg8::gemm_phase(lds, g, S, E); }
        if (l == 0) { __syncthreads(); pg8::Gemm g{(const bf16_t*)(ws + OFF_ACC), (const bf16_t*)(ws + OFF_WOUT), MT, 2048, 256, 2048, 2048}; pg8::Sched S; S.init_split(64, 2, 2048, 8, 256, G, cb);
          pg8::EpiPart E{(float*)(ws + OFF_PREP), 256}; pg8::gemm_phase(lds, g, S, E); } }
    if constexpr (PH == 9) phase_norm(XB, (l == 0) ? p.ctx : XB + (size_t)ML * 2048, p.norm_ffn_w + l * 2048, modl, 3 * 2048, 4 * 2048, HX, Mx, (const float*)(ws + OFF_PREP), (l == 0) ? 8 : 0, modl + 2 * 12288 + 2 * 2048, XB);
    if constexpr (PH == 10) { pg8::Gemm g{HX, (const bf16_t*)(ws + OFF_W1), Mx, 8192, 2048, 2048, 2048}; pg8::Sched S; S.init(Mx, 8192, G, cb, 1);
        pg8::EpiB16<2, 8192> E{(bf16_t*)(ws + OFF_F), nullptr}; pg8::gemm_phase(lds, g, S, E); }
    if constexpr (PH == 11) { { pg8::Gemm g{(const bf16_t*)(ws + OFF_F), (const bf16_t*)(ws + OFF_W2), ML, 2048, 8192, 8192, 8192}; pg8::Sched S; S.init(ML, 2048, G, cb, 1);
          pg8::EpiRes E{XB, XB + (size_t)ML * 2048, XB, modl, 5 * 2048}; pg8::gemm_phase(lds, g, S, E); }
        if (l == 0) { __syncthreads(); pg8::Gemm g{(const bf16_t*)(ws + OFF_F), (const bf16_t*)(ws + OFF_W2), MT, 2048, 512, 8192, 8192}; pg8::Sched S; S.init_split(64, 2, 2048, 16, 512, G, cb);
          pg8::EpiPart E{(float*)(ws + OFF_PREP), 512}; pg8::gemm_phase(lds, g, S, E); } }
    if constexpr (PH == 12) phase_final_norm(XB, p.final_norm_w, p.out);
}

#ifndef SINGLE_LAUNCH
#define SINGLE_LAUNCH 1
#endif

#if SINGLE_LAUNCH
__global__ void __launch_bounds__(512, 2) mega(Params p) {
    extern __shared__ __attribute__((aligned(16))) unsigned char smem[];
    LAS unsigned char* lds = (LAS unsigned char*)smem;
    cg::grid_group grid = cg::this_grid();
    volatile LAS unsigned* bst = (volatile LAS unsigned*)(lds + LDS_BYTES - 16);
    if (threadIdx.x < 4) bst[threadIdx.x] = 0u;
    __syncthreads();
    const XcdBarrier xbar = xcd_barrier_post((unsigned*)(p.ws + OFF_BAR), bst);
#ifndef DBL_MASK
#define DBL_MASK 0
#endif
#define RUNPH(ph, l) do { do_phase<ph>(p, l, lds); xcd_barrier(xbar, (unsigned*)(p.ws + OFF_BAR)); if (DBL_MASK & (1 << (ph))) { do_phase<ph>(p, l, lds); xcd_barrier(xbar, (unsigned*)(p.ws + OFF_BAR)); } } while (0)
    if (p.ws == nullptr) grid.sync();
    do_phase<0>(p, 0, lds); xcd_barrier(xbar, (unsigned*)(p.ws + OFF_BAR));
    for (int l = 0; l < 2; ++l) {
        RUNPH(1, l); RUNPH(2, l); RUNPH(13, l); do_phase<14>(p, l, lds); __syncthreads(); do_phase<15>(p, l, lds); xcd_barrier(xbar, (unsigned*)(p.ws + OFF_BAR)); RUNPH(3, l); RUNPH(4, l);
#ifdef SCAN_PROBE_MASK
        do_phase<14>(p, l, lds); xcd_barrier(xbar, (unsigned*)(p.ws + OFF_BAR));
#endif
        RUNPH(5, l); RUNPH(6, l); RUNPH(7, l); RUNPH(8, l); RUNPH(9, l); RUNPH(10, l); RUNPH(11, l);
    }
    do_phase<12>(p, 0, lds);
}
#else
template <int PH> __global__ void __launch_bounds__(512, 2) k_phase(Params p, int l) {
    extern __shared__ __attribute__((aligned(16))) unsigned char smem[];
    do_phase<PH>(p, l, (LAS unsigned char*)smem);
}
template <int PH> static void launch_phase(const Params& p, int l, int grid, hipStream_t stream) {
    static bool attr = false;
    if (!attr) { (void)hipFuncSetAttribute((const void*)k_phase<PH>, hipFuncAttributeMaxDynamicSharedMemorySize, LDS_BYTES); attr = true; }
    hipLaunchKernelGGL(k_phase<PH>, dim3(grid), dim3(512), LDS_BYTES, stream, p, l);
}
#endif

extern "C" void kernel_launch(void* const* d_in, const int* in_sizes, int n_in, void* d_out, int out_size, void* d_ws, size_t ws_size, hipStream_t stream) {
    static int grid_blocks = 0;
    if (grid_blocks == 0) {
        if (n_in != 38 || ws_size < WS_END) { fprintf(stderr, "kernel_launch: need 38 inputs and >= %zu bytes of workspace (got %d, %zu)\n", (size_t)WS_END, n_in, ws_size); grid_blocks = -1; return; }
        int dev = 0, cus = 0;
        (void)hipGetDevice(&dev);
        (void)hipDeviceGetAttribute(&cus, hipDeviceAttributeMultiprocessorCount, dev);
#if SINGLE_LAUNCH
        int per_cu = 0;
        if (hipFuncSetAttribute((const void*)mega, hipFuncAttributeMaxDynamicSharedMemorySize, LDS_BYTES) != hipSuccess) { fprintf(stderr, "kernel_launch: hipFuncSetAttribute failed\n"); grid_blocks = -1; return; }
        if (hipOccupancyMaxActiveBlocksPerMultiprocessor(&per_cu, (const void*)mega, 512, LDS_BYTES) != hipSuccess || per_cu < 1) { fprintf(stderr, "kernel_launch: occupancy query says %d blocks per CU\n", per_cu); (void)hipGetLastError(); per_cu = 1; }
        grid_blocks = cus * per_cu;
#else
        grid_blocks = cus;
#endif
    }
    if (grid_blocks < 0) return;
    Params p{};
    const float** dst = (const float**)&p;
    for (int i = 0; i < 38; ++i) dst[i] = (const float*)d_in[i];
    p.out = (float*)d_out; p.ws = (unsigned char*)d_ws;
#if SINGLE_LAUNCH
    (void)hipMemsetAsync((unsigned char*)d_ws + OFF_BAR, 0, 16384, stream);
    void* args[] = {&p};
    hipError_t e = hipLaunchCooperativeKernel((const void*)mega, dim3(grid_blocks), dim3(512), args, LDS_BYTES, stream);
    if (e != hipSuccess) fprintf(stderr, "cooperative launch failed: %s (grid %d)\n", hipGetErrorString(e), grid_blocks);
#else
    const int g = grid_blocks;
    launch_phase<0>(p, 0, g, stream);
    for (int l = 0; l < 2; ++l) {
        launch_phase<1>(p, l, g, stream); launch_phase<2>(p, l, g, stream); launch_phase<3>(p, l, g, stream); launch_phase<4>(p, l, g, stream);
        launch_phase<5>(p, l, g, stream); launch_phase<6>(p, l, g, stream); launch_phase<7>(p, l, g, stream); launch_phase<8>(p, l, g, stream);
        launch_phase<9>(p, l, g, stream); launch_phase<10>(p, l, g, stream); launch_phase<11>(p, l, g, stream);
    }
    launch_phase<12>(p, 0, g, stream);
#endif
}
```
